# Optimizing an MI355X kernel written in HIP

```python
import jax, jax.numpy as jnp
from jax import lax
import numpy as np

D_MODEL = 1024
BATCH = 8
SEQ = 4096
DEPTH = 1

GLA_HEADS = 4
GLA_DK = D_MODEL // 2 // GLA_HEADS
GLA_DV = D_MODEL // GLA_HEADS
GLA_QK = GLA_HEADS * GLA_DK
GLA_VW = GLA_HEADS * GLA_DV
GLA_LOWRANK = 16
GLA_TAU = 16.0
GLA_CHUNK = 64
SB_HEADS = 8
SB_DH = D_MODEL // SB_HEADS
SB_W = SB_HEADS * SB_DH
SB_BLOCK = 128
D_FF = -(-(8 * D_MODEL) // (3 * 256)) * 256
ALPHA = (2.0 * DEPTH) ** 0.25
BETA = (8.0 * DEPTH) ** -0.25
LN_EPS = 1e-5
IN_SPLITS = (GLA_QK, GLA_QK, GLA_VW, GLA_VW, GLA_LOWRANK, SB_W, SB_W, SB_W, D_MODEL, D_MODEL)
IN_WIDTH = 8208

kernel_name = "hybrid_gla_stickbreaking_deepnorm_adaln"


def _layer_norm(x):
    xf = x.astype(jnp.float32)
    mu = jnp.mean(xf, axis=-1, keepdims=True)
    var = jnp.mean(jnp.square(xf - mu), axis=-1, keepdims=True)
    return (xf - mu) * lax.rsqrt(var + LN_EPS)


def _rms_norm(x):
    xf = x.astype(jnp.float32)
    return xf * lax.rsqrt(jnp.mean(jnp.square(xf), axis=-1, keepdims=True) + LN_EPS)


def _split_cols(h):
    idx = [int(i) for i in np.cumsum(IN_SPLITS)[:-1]]
    return jnp.split(h, idx, axis=-1)


def _gla(q, k, v, log_a):
    B, S, H, dk = q.shape
    dv = v.shape[-1]
    n = S // GLA_CHUNK

    def to_chunks(t):
        return t.reshape(B, n, GLA_CHUNK, H, t.shape[-1]).transpose(1, 0, 3, 2, 4)

    qc = to_chunks(q.astype(jnp.float32))
    kc = to_chunks(k.astype(jnp.float32))
    vc = to_chunks(v.astype(jnp.float32))
    bc = jnp.cumsum(to_chunks(log_a.astype(jnp.float32)), axis=3)
    causal = jnp.tril(jnp.ones((GLA_CHUNK, GLA_CHUNK), dtype=bool))

    def step(state, inp):
        qi, ki, vi, bi = inp
        o_inter = jnp.einsum('bhcd,bhde->bhce', qi * jnp.exp(bi), state)
        diff = bi[:, :, :, None, :] - bi[:, :, None, :, :]
        decay = jnp.exp(jnp.where(causal[:, :, None], diff, -jnp.inf))
        scores = jnp.einsum('bhtd,bhsd,bhtsd->bhts', qi, ki, decay)
        o_intra = jnp.einsum('bhts,bhse->bhte', scores, vi)
        b_last = bi[:, :, -1:, :]
        k_dec = ki * jnp.exp(b_last - bi)
        state = state * jnp.exp(b_last)[:, :, 0, :, None] + jnp.einsum('bhcd,bhce->bhde', k_dec, vi)
        return state, o_inter + o_intra

    state0 = jnp.zeros((B, H, dk, dv), jnp.float32)
    _, o = lax.scan(step, state0, (qc, kc, vc, bc))
    return o.transpose(1, 0, 3, 2, 4).reshape(B, S, H, dv)


def _stick_breaking(q, k, v):
    S = q.shape[2]
    qf, kf, vf = q.astype(jnp.float32), k.astype(jnp.float32), v.astype(jnp.float32)
    outs = []
    for blk in range(S // SB_BLOCK):
        q0 = blk * SB_BLOCK
        kend = q0 + SB_BLOCK
        z = jnp.einsum('bhtd,bhsd->bhts', qf[:, :, q0:kend], kf[:, :, :kend]) * (SB_DH ** -0.5)
        t_idx = q0 + jnp.arange(SB_BLOCK)[:, None]
        s_idx = jnp.arange(kend)[None, :]
        mask = s_idx < t_idx
        log_keep = jnp.where(mask, jax.nn.log_sigmoid(-z), 0.0)
        after = lax.cumsum(log_keep, axis=3, reverse=True) - log_keep
        w = jnp.where(mask, jnp.exp(jax.nn.log_sigmoid(z) + after), 0.0)
        outs.append(jnp.einsum('bhts,bhse->bhte', w, vf[:, :, :kend]))
    return jnp.concatenate(outs, axis=2)


def setup_inputs(seed: int = 0) -> dict:
    key = jax.random.key(seed)
    ks = jax.random.split(key, 16)

    def nrm(k, shape, s):
        return jax.random.normal(k, shape, jnp.float32) * s

    L = DEPTH
    return {
        "x": nrm(ks[0], (BATCH, SEQ, D_MODEL), 1.0),
        "c": nrm(ks[1], (BATCH, D_MODEL), 1.0),
        "w_ada": nrm(ks[2], (L, D_MODEL, 6 * D_MODEL), 0.5 * D_MODEL ** -0.5),
        "b_ada": nrm(ks[3], (L, 6 * D_MODEL), 0.02),
        "w_in": nrm(ks[4], (L, D_MODEL, IN_WIDTH), D_MODEL ** -0.5),
        "w_alpha_up": nrm(ks[5], (L, GLA_LOWRANK, GLA_QK), GLA_LOWRANK ** -0.5),
        "b_alpha": nrm(ks[6], (L, GLA_QK), 0.1),
        "gla_norm_g": 1.0 + nrm(ks[7], (L, GLA_VW), 0.02),
        "w_out": nrm(ks[8], (L, D_MODEL, D_MODEL), BETA * D_MODEL ** -0.5),
        "ln1_g": 1.0 + nrm(ks[9], (L, D_MODEL), 0.02),
        "ln1_b": nrm(ks[10], (L, D_MODEL), 0.02),
        "w_ffn_in": nrm(ks[11], (L, D_MODEL, 2 * D_FF), D_MODEL ** -0.5),
        "w_ffn_out": nrm(ks[12], (L, D_FF, D_MODEL), BETA * D_FF ** -0.5),
        "ln2_g": 1.0 + nrm(ks[13], (L, D_MODEL), 0.02),
        "ln2_b": nrm(ks[14], (L, D_MODEL), 0.02),
    }


def reference(x, c, w_ada, b_ada, w_in, w_alpha_up, b_alpha, gla_norm_g, w_out,
              ln1_g, ln1_b, w_ffn_in, w_ffn_out, ln2_g, ln2_b):
    dtype = x.dtype
    B, S, D = x.shape
    c_act = jax.nn.silu(c)
    for l in range(DEPTH):
        mod = c_act @ w_ada[l] + b_ada[l]
        shift1, scale1, gate1, shift2, scale2, gate2 = [m[:, None, :] for m in jnp.split(mod, 6, axis=-1)]

        u = (_layer_norm(x) * (1.0 + scale1) + shift1).astype(dtype)
        h = u @ w_in[l]
        gq, gk, gv, gg, ga, sq, sk, sv, ma, mb = _split_cols(h)

        log_a = jax.nn.log_sigmoid((ga @ w_alpha_up[l] + b_alpha[l]).astype(jnp.float32)) / GLA_TAU
        q_g = gq.reshape(B, S, GLA_HEADS, GLA_DK) * (GLA_DK ** -0.5)
        k_g = gk.reshape(B, S, GLA_HEADS, GLA_DK)
        v_g = gv.reshape(B, S, GLA_HEADS, GLA_DV)
        o_g = _gla(q_g, k_g, v_g, log_a.reshape(B, S, GLA_HEADS, GLA_DK))
        o_g = _rms_norm(o_g).reshape(B, S, GLA_VW) * gla_norm_g[l] * jax.nn.silu(gg.astype(jnp.float32))

        def to_bhsd(t):
            return t.reshape(B, S, SB_HEADS, SB_DH).transpose(0, 2, 1, 3)
        o_s = _stick_breaking(to_bhsd(sq), to_bhsd(sk), to_bhsd(sv))
        o_s = o_s.transpose(0, 2, 1, 3).reshape(B, S, SB_W)

        merged = (jax.nn.sigmoid(ma.astype(jnp.float32)) * o_g
                  + jax.nn.sigmoid(mb.astype(jnp.float32)) * o_s).astype(dtype)
        y = merged @ w_out[l]
        x = (_layer_norm(ALPHA * x + (1.0 + gate1) * y) * ln1_g[l] + ln1_b[l]).astype(dtype)

        u2 = (_layer_norm(x) * (1.0 + scale2) + shift2).astype(dtype)
        g_ff, up_ff = jnp.split(u2 @ w_ffn_in[l], 2, axis=-1)
        f = (jax.nn.silu(g_ff) * up_ff) @ w_ffn_out[l]
        x = (_layer_norm(ALPHA * x + (1.0 + gate2) * f) * ln2_g[l] + ln2_b[l]).astype(dtype)
    return x
```

```cpp
#include <hip/hip_runtime.h>
#include <hip/hip_cooperative_groups.h>
#include <cstdio>
#include <cstdint>
namespace cg = cooperative_groups;
namespace pg8 {
#define PG8_LAS __attribute__((address_space(3)))
typedef unsigned short bf16_t;
typedef short bf16x8 __attribute__((ext_vector_type(8)));
typedef float f32x4 __attribute__((ext_vector_type(4)));
typedef unsigned u32x4 __attribute__((ext_vector_type(4)));
constexpr int BM = 256, BK = 64, HALF = 128, HTB = HALF * BK * 2  , STAGE_BYTES = 8 * HTB, NXCD = 8, WGM = 8;

__host__ __device__ __forceinline__ int lds_byte(int r, int c) { const int st = (r >> 4) * 2 + (c >> 5), rr = r & 15, cc = c & 31, ob = rr * 64 + cc * 2; return st * 1024 + (ob ^ (((ob >> 9) & 1) << 5)); }
__host__ __device__ __forceinline__ void stage_rc(int b, int& R, int& C) { const int st = b / 1024, sb = b % 1024, swz = sb ^ (((sb >> 9) & 1) << 5); R = (st >> 1) * 16 + swz / 64; C = (st & 1) * 32 + (swz % 64) / 2; }
__host__ __device__ __forceinline__ int perm32(int rho) { const int n = rho >> 4, i = rho & 15; return 8 * (i >> 2) + 4 * n + (i & 3); }

struct Unit { int pm, pn; };
struct Gemm { const bf16_t* A; const bf16_t* Bt; int M, N, K, lda; };

struct StaticOrder {
    int nM, nN, nwg, G, c;
    __host__ __device__ void init(int M, int N, int G_, int c_) { nM = M / BM; nN = N / BM; nwg = nM * nN; G = G_; c = c_; }
    __host__ __device__ bool next(int i, Unit& u) const {
        const long L = (long)i * G + c; if (L >= nwg) return false;
        int wgid = (int)L; { const int q = nwg / NXCD, r = nwg % NXCD, xcd = wgid % NXCD, off = wgid / NXCD; wgid = (xcd < r ? xcd * (q + 1) : r * (q + 1) + (xcd - r) * q) + off; }
        const int nig = WGM * nN, gid = wgid / nig, fm = gid * WGM, gsz = (nM - fm) < WGM ? (nM - fm) : WGM;
        u.pm = fm + ((wgid % nig) % gsz); u.pn = (wgid % nig) / gsz; return true;
    }
    __device__ __forceinline__ void a_ready(const Unit&) const {}
    __device__ __forceinline__ void done(const Unit&) const {}
};

__device__ __forceinline__ unsigned cvt_pk_bf16(float lo, float hi) { unsigned r; asm volatile("v_cvt_pk_bf16_f32 %0, %1, %2" : "=v"(r) : "v"(lo), "v"(hi)); return r; }
typedef __bf16 bf16x2_t __attribute__((ext_vector_type(2)));
typedef float f32x2_t __attribute__((ext_vector_type(2)));
typedef unsigned u32x2 __attribute__((ext_vector_type(2)));
__device__ __forceinline__ unsigned cvtpk(float lo, float hi) { f32x2_t v = {lo, hi}; bf16x2_t b = __builtin_convertvector(v, bf16x2_t); return __builtin_bit_cast(unsigned, b); }

struct EpiH {
    static constexpr bool PERM = true, AFTER_DRAIN = false;
    bf16_t* H; bf16_t* GA;
    __device__ __forceinline__ void operator()(const f32x4 (&acc)[2][2][4][2], const Unit& u, int wr, int wc, int fr, int fq) const {
        const int row0 = u.pm * BM + wr * 64 + fr;
        if (u.pn < 32) {
            const int col0 = u.pn * BM + wc * 32 + 8 * fq;
#pragma unroll
            for (int ai = 0; ai < 2; ++ai)
#pragma unroll
                for (int m = 0; m < 4; ++m) { bf16_t* rowp = H + (size_t)(row0 + ai * HALF + m * 16) * 8192 + col0;
#pragma unroll
                    for (int bj = 0; bj < 2; ++bj) { const f32x4 v0 = acc[ai][bj][m][0], v1 = acc[ai][bj][m][1];
                        u32x4 w; w.x = cvtpk(v0[0], v0[1]); w.y = cvtpk(v0[2], v0[3]); w.z = cvtpk(v1[0], v1[1]); w.w = cvtpk(v1[2], v1[3]);
                        *(u32x4*)(rowp + bj * HALF) = w; } }
        } else if (wc == 0 && fq < 2) {
#pragma unroll
            for (int ai = 0; ai < 2; ++ai)
#pragma unroll
                for (int m = 0; m < 4; ++m) { const f32x4 v0 = acc[ai][0][m][0], v1 = acc[ai][0][m][1];
                    u32x4 w; w.x = cvtpk(v0[0], v0[1]); w.y = cvtpk(v0[2], v0[3]); w.z = cvtpk(v1[0], v1[1]); w.w = cvtpk(v1[2], v1[3]);
                    *(u32x4*)(GA + (size_t)(row0 + ai * HALF + m * 16) * 16 + 8 * fq) = w; }
        }
    }
};
struct EpiRes {
    static constexpr bool PERM = false, AFTER_DRAIN = false;
    const float* X; int ldx; float* O; int ldo; const float* gate; float alpha;
    __device__ __forceinline__ void operator()(const f32x4 (&acc)[2][2][4][2], const Unit& u, int wr, int wc, int fr, int fq) const {
        const int b = u.pm >> 4; const int col0 = u.pn * BM + wc * 32 + 4 * fq;
#pragma unroll
        for (int bj = 0; bj < 2; ++bj)
#pragma unroll
            for (int n = 0; n < 2; ++n) { const int c = col0 + bj * HALF + n * 16; const f32x4 gv = *(const f32x4*)(gate + (size_t)b * 6144 + c) + 1.0f;
#pragma unroll
                for (int ai = 0; ai < 2; ++ai)
#pragma unroll
                    for (int m = 0; m < 4; ++m) { const size_t r = (size_t)(u.pm * BM + ai * HALF + wr * 64 + m * 16 + fr);
                        const f32x4 xv = *(const f32x4*)(X + r * ldx + c); *(f32x4*)(O + r * ldo + c) = xv * alpha + gv * acc[ai][bj][m][n]; } }
    }
};
struct EpiSwiglu {
    static constexpr bool PERM = true, AFTER_DRAIN = false;
    bf16_t* O; int ldo;
    __device__ __forceinline__ void operator()(const f32x4 (&acc)[2][2][4][2], const Unit& u, int wr, int wc, int fr, int fq) const {
        const int row0 = u.pm * BM + wr * 64 + fr; const int col0 = u.pn * HALF + wc * 32 + 8 * fq;
#pragma unroll
        for (int ai = 0; ai < 2; ++ai)
#pragma unroll
            for (int m = 0; m < 4; ++m) { float a[8];
#pragma unroll
                for (int n = 0; n < 2; ++n)
#pragma unroll
                    for (int j = 0; j < 4; ++j) { const float g = acc[ai][0][m][n][j], up = acc[ai][1][m][n][j]; a[4 * n + j] = g * __builtin_amdgcn_rcpf(1.0f + __expf(-g)) * up; }
                u32x4 w; w.x = cvtpk(a[0], a[1]); w.y = cvtpk(a[2], a[3]); w.z = cvtpk(a[4], a[5]); w.w = cvtpk(a[6], a[7]);
                *(u32x4*)(O + (size_t)(row0 + ai * HALF + m * 16) * ldo + col0) = w; }
    }
};

template <class Epi, class Sched, bool ALIGN_EPI = false, bool SP2 = false>
__device__ __forceinline__ void gemm_phase(PG8_LAS unsigned char* lds, const Gemm g, const Sched& S, const Epi& E) {
    const int tid = threadIdx.x, wid = __builtin_amdgcn_readfirstlane(tid >> 6), lane = tid & 63, wr = wid >> 2, wc = wid & 3, fr = lane & 15, fq = lane >> 4;
    const int K = g.K, nt = K / BK;
    unsigned voffA[2], voffB[2];
#pragma unroll
    for (int i = 0; i < 2; ++i) { int R, C; stage_rc(tid * 16 + i * 8192, R, C); const int Rb = Epi::PERM ? ((R & ~31) + perm32(R & 31)) : R;
        voffA[i] = (unsigned)(R * g.lda + C) * 2u; voffB[i] = (unsigned)(Rb * K + C) * 2u; }
    const size_t kstep = (size_t)(BK * 2);
    const size_t hstepA = (size_t)HALF * g.lda * 2, hstepB = (size_t)HALF * K * 2;
    const size_t tstepA = 2 * hstepA, tstepB = 2 * hstepB;
    const unsigned ldsw = (unsigned)wid * 1024u;
    const int aoff = lds_byte(wr * 64 + fr, fq * 8), boff = lds_byte(wc * 32 + fr, fq * 8);
#define PG8_SA(b, h) (((b) * 2 + (h)) * HTB)
#define PG8_SB(b, h) ((4 + (b) * 2 + (h)) * HTB)
#define PG8_STAGE(bufoff, gbase, voff) do { _Pragma("unroll") for (int _i = 0; _i < 2; ++_i) \
        __builtin_amdgcn_global_load_lds((const unsigned*)((const char*)(gbase) + (voff)[_i]), (PG8_LAS unsigned*)(lds + (bufoff) + ldsw + _i * 8192), 16, 0, 0); } while (0)
#define PG8_LDA(dst, b, h) do { _Pragma("unroll") for (int m = 0; m < 4; ++m) _Pragma("unroll") for (int k = 0; k < 2; ++k) dst[m][k] = *(const PG8_LAS bf16x8*)(lds + PG8_SA(b, h) + aoff + m * 2048 + k * 1024); } while (0)
#define PG8_LDB(dst, b, h) do { _Pragma("unroll") for (int n = 0; n < 2; ++n) _Pragma("unroll") for (int k = 0; k < 2; ++k) dst[n][k] = *(const PG8_LAS bf16x8*)(lds + PG8_SB(b, h) + boff + n * 2048 + k * 1024); } while (0)
#define PG8_MMA(ai, bj, At, Bt) do { __builtin_amdgcn_s_setprio(1); _Pragma("unroll") for (int m = 0; m < 4; ++m) _Pragma("unroll") for (int n = 0; n < 2; ++n) _Pragma("unroll") for (int k = 0; k < 2; ++k) \
        acc[ai][bj][m][n] = __builtin_amdgcn_mfma_f32_16x16x32_bf16(Bt[n][k], At[m][k], acc[ai][bj][m][n], 0, 0, 0); __builtin_amdgcn_s_setprio(0); } while (0)
#define PG8_WAIT_V(n) asm volatile("s_waitcnt vmcnt(" #n ")" ::: "memory")
#define PG8_WAIT_L(n) asm volatile("s_waitcnt lgkmcnt(" #n ")" ::: "memory")
#define PG8_BAR __builtin_amdgcn_s_barrier()
#define PG8_SCHED __builtin_amdgcn_sched_barrier(0)
    Unit cur, nxt; int ui = 0;
    if (!S.next(0, cur)) return;
    f32x4 acc[2][2][4][2];
#pragma unroll
    for (int a = 0; a < 2; ++a)
#pragma unroll
        for (int b = 0; b < 2; ++b)
#pragma unroll
            for (int m = 0; m < 4; ++m)
#pragma unroll
                for (int n = 0; n < 2; ++n) acc[a][b][m][n] = (f32x4){0.f, 0.f, 0.f, 0.f};
    bf16x8 At[4][2], B0[2][2], B1[2][2];
    const char* cA = (const char*)g.A + (size_t)cur.pm * tstepA; const char* cB = (const char*)g.Bt + (size_t)cur.pn * tstepB;
    S.a_ready(cur);
    if constexpr (SP2) {
        PG8_STAGE(PG8_SB(0, 0), cB, voffB); PG8_STAGE(PG8_SB(0, 1), cB + hstepB, voffB); PG8_STAGE(PG8_SA(0, 0), cA, voffA); PG8_STAGE(PG8_SA(0, 1), cA + hstepA, voffA);
        if (wr == 1) PG8_BAR;
        PG8_WAIT_V(2); PG8_BAR;
        PG8_STAGE(PG8_SB(1, 0), cB + kstep, voffB); PG8_STAGE(PG8_SA(1, 0), cA + kstep, voffA); PG8_STAGE(PG8_SB(1, 1), cB + hstepB + kstep, voffB);
        PG8_WAIT_V(6); PG8_BAR;
    } else {
        PG8_STAGE(PG8_SB(0, 0), cB, voffB); PG8_STAGE(PG8_SA(0, 0), cA, voffA); PG8_STAGE(PG8_SB(0, 1), cB + hstepB, voffB); PG8_STAGE(PG8_SA(0, 1), cA + hstepA, voffA);
        if (wr == 1) PG8_BAR;
        PG8_WAIT_V(4); PG8_BAR;
        PG8_STAGE(PG8_SB(1, 0), cB + kstep, voffB); PG8_STAGE(PG8_SA(1, 0), cA + kstep, voffA); PG8_STAGE(PG8_SB(1, 1), cB + hstepB + kstep, voffB);
        PG8_WAIT_V(6); PG8_BAR;
    }
    for (;;) {
        const bool has_next = S.next(ui + 1, nxt);
        const char* nA = has_next ? (const char*)g.A + (size_t)nxt.pm * tstepA : cA; const char* nB = has_next ? (const char*)g.Bt + (size_t)nxt.pn * tstepB : cB;
        for (int t = 0; t < nt; t += 2) {
            const bool last = (t == nt - 2);
            const char* a1 = cA + (size_t)(t + 1) * kstep;
            const char* a2 = last ? nA : cA + (size_t)(t + 2) * kstep; const char* b2 = last ? nB : cB + (size_t)(t + 2) * kstep;
            const char* a3 = a2 + kstep; const char* b3 = b2 + kstep;
            if (last && has_next) S.a_ready(nxt);
            if constexpr (SP2) {
            PG8_LDB(B0, 0, 0); PG8_LDB(B1, 0, 1); PG8_SCHED; PG8_LDA(At, 0, 0); PG8_STAGE(PG8_SA(1, 1), a1 + hstepA, voffA);
            PG8_WAIT_V(8); PG8_WAIT_L(0); PG8_BAR; PG8_MMA(0, 0, At, B0); PG8_MMA(0, 1, At, B1); PG8_BAR; PG8_SCHED;
            PG8_LDA(At, 0, 1); PG8_STAGE(PG8_SB(0, 0), b2, voffB); PG8_STAGE(PG8_SB(0, 1), b2 + hstepB, voffB); PG8_STAGE(PG8_SA(0, 0), a2, voffA);
            PG8_WAIT_V(8); PG8_WAIT_L(0); PG8_BAR; PG8_MMA(1, 0, At, B0); PG8_MMA(1, 1, At, B1); PG8_BAR; PG8_SCHED;
            PG8_LDB(B0, 1, 0); PG8_LDB(B1, 1, 1); PG8_SCHED; PG8_LDA(At, 1, 0); PG8_STAGE(PG8_SA(0, 1), a2 + hstepA, voffA);
            PG8_WAIT_V(8); PG8_WAIT_L(0); PG8_BAR; PG8_MMA(0, 0, At, B0); PG8_MMA(0, 1, At, B1); PG8_BAR; PG8_SCHED;
            PG8_LDA(At, 1, 1); PG8_STAGE(PG8_SB(1, 0), b3, voffB); PG8_STAGE(PG8_SB(1, 1), b3 + hstepB, voffB); PG8_STAGE(PG8_SA(1, 0), a3, voffA);
            PG8_WAIT_V(8); PG8_WAIT_L(0); PG8_BAR; PG8_MMA(1, 0, At, B0); PG8_MMA(1, 1, At, B1); PG8_BAR; PG8_SCHED;
            } else {
            PG8_LDB(B0, 0, 0); PG8_SCHED; PG8_LDA(At, 0, 0); PG8_STAGE(PG8_SA(1, 1), a1 + hstepA, voffA);
            PG8_WAIT_L(8); PG8_BAR; PG8_WAIT_L(0); PG8_MMA(0, 0, At, B0); PG8_BAR; PG8_SCHED;
            PG8_LDB(B1, 0, 1); PG8_STAGE(PG8_SB(0, 0), b2, voffB);
            PG8_BAR; PG8_WAIT_L(0); PG8_MMA(0, 1, At, B1); PG8_BAR;
            PG8_LDA(At, 0, 1); PG8_STAGE(PG8_SA(0, 0), a2, voffA);
            PG8_BAR; PG8_WAIT_L(0); PG8_MMA(1, 0, At, B0); PG8_BAR; PG8_SCHED;
            PG8_STAGE(PG8_SB(0, 1), b2 + hstepB, voffB);
            PG8_WAIT_V(6); PG8_BAR; PG8_MMA(1, 1, At, B1); PG8_BAR;
            PG8_LDB(B0, 1, 0); PG8_SCHED; PG8_LDA(At, 1, 0); PG8_STAGE(PG8_SA(0, 1), a2 + hstepA, voffA);
            PG8_WAIT_L(8); PG8_BAR; PG8_WAIT_L(0); PG8_MMA(0, 0, At, B0); PG8_BAR; PG8_SCHED;
            PG8_LDB(B1, 1, 1); PG8_STAGE(PG8_SB(1, 0), b3, voffB);
            PG8_BAR; PG8_WAIT_L(0); PG8_MMA(0, 1, At, B1); PG8_BAR;
            PG8_LDA(At, 1, 1); PG8_STAGE(PG8_SA(1, 0), a3, voffA);
            PG8_BAR; PG8_WAIT_L(0); PG8_MMA(1, 0, At, B0); PG8_BAR; PG8_SCHED;
            PG8_STAGE(PG8_SB(1, 1), b3 + hstepB, voffB);
            PG8_WAIT_V(6); PG8_BAR; PG8_MMA(1, 1, At, B1); PG8_BAR;
            }
        }
        if constexpr (ALIGN_EPI) { if (wr == 0) PG8_BAR; }
        if constexpr (!Epi::AFTER_DRAIN) { E(acc, cur, wr, wc, fr, fq); S.done(cur); }
        if (!has_next) break;
#pragma unroll
        for (int a = 0; a < 2; ++a)
#pragma unroll
            for (int b = 0; b < 2; ++b)
#pragma unroll
                for (int m = 0; m < 4; ++m)
#pragma unroll
                    for (int n = 0; n < 2; ++n) acc[a][b][m][n] = (f32x4){0.f, 0.f, 0.f, 0.f};
        cur = nxt; cA = nA; cB = nB; ++ui;
        if constexpr (ALIGN_EPI) { if (wr == 1) PG8_BAR; }
    }
    PG8_WAIT_V(0);
    if constexpr (!ALIGN_EPI) { if (wr == 0) PG8_BAR; }
    PG8_BAR;
    if constexpr (Epi::AFTER_DRAIN) { E.fused(acc, cur, wr, wc, fr, fq, lds, wid, lane); S.done(cur); }
#undef PG8_SA
#undef PG8_SB
#undef PG8_STAGE
#undef PG8_LDA
#undef PG8_LDB
#undef PG8_MMA
#undef PG8_WAIT_V
#undef PG8_WAIT_L
#undef PG8_BAR
#undef PG8_SCHED
}
}
#ifndef PG8_SP2
#define PG8_SP2 true
#endif
#ifndef PG8_ALIGN
#define PG8_ALIGN true
#endif
#define LAS __attribute__((address_space(3)))
typedef unsigned short bf16;
typedef short bf16x8 __attribute__((ext_vector_type(8)));
typedef short s16x4 __attribute__((ext_vector_type(4)));
typedef float f32x4 __attribute__((ext_vector_type(4)));
typedef float f32x16 __attribute__((ext_vector_type(16)));
typedef unsigned v4u __attribute__((ext_vector_type(4)));
typedef unsigned v2u __attribute__((ext_vector_type(2)));
using pg8::cvtpk;
constexpr int NWAVES = 8, NTHR = 512;
constexpr int BATCH = 8, SEQ = 4096, D = 1024, M = BATCH * SEQ, FF = 2816, NMOD = 6 * D;
constexpr int HW = 8192;
constexpr int C_GQ = 0, C_GK = 512, C_GV = 1024, C_GG = 2048, C_SQ = 3072, C_SK = 4096, C_SV = 5120, C_MA = 6144, C_MB = 7168;
constexpr int NIN = 8448;
constexpr int C_U2 = 0, C_ACT = 1024;
constexpr int HROWF = 4096, F_R = 2048, F_X1 = 3072;
constexpr float LN_EPS = 1e-5f, ALPHA = 1.189207115002721f;
constexpr float QK_SCALE = 0.08838834764831845f;
constexpr size_t MiB = 1u << 20;
constexpr size_t DO_U1 = 0, DO_WIN = 64 * MiB, DO_WOUT = 81 * MiB, DO_WFFIN = 85 * MiB, DO_WFFOUT = 96 * MiB, DO_GA = 102 * MiB, DO_MODP = 103 * MiB, DO_MODF = 106 * MiB;
static_assert(DO_WIN + (size_t)NIN * D * 2 <= DO_WOUT && DO_WOUT + (size_t)D * 2048 * 2 <= DO_WFFIN && DO_WFFIN + (size_t)2 * FF * D * 2 <= DO_WFFOUT && DO_WFFOUT + (size_t)D * FF * 2 <= DO_GA &&
              DO_GA + (size_t)M * 16 * 2 <= DO_MODP && DO_MODP + (size_t)16 * BATCH * NMOD * 4 <= DO_MODF && DO_MODF + (size_t)BATCH * NMOD * 4 <= 128 * MiB, "d_out scratch map");
constexpr int LDS_BYTES = 147456;

__device__ __forceinline__ float bf2f(unsigned short u) { return __uint_as_float((unsigned)u << 16); }
__device__ __forceinline__ float wave_sum(float v) {
#pragma unroll
    for (int o = 1; o < 64; o <<= 1) v += __shfl_xor(v, o);
    return v;
}
__device__ __forceinline__ int crow(int reg, int h) { return (reg & 3) + 8 * (reg >> 2) + 4 * h; }
#define MFMA32(a, b, c) __builtin_amdgcn_mfma_f32_32x32x16_bf16((a), (b), (c), 0, 0, 0)
__device__ __forceinline__ bf16x8 pack8(float a0, float a1, float a2, float a3, float a4, float a5, float a6, float a7) {
    v4u p; p.x = cvtpk(a0, a1); p.y = cvtpk(a2, a3); p.z = cvtpk(a4, a5); p.w = cvtpk(a6, a7); return __builtin_bit_cast(bf16x8, p);
}
#define PACK_STEP(x, s) pack8((x)[8 * (s)], (x)[8 * (s) + 1], (x)[8 * (s) + 2], (x)[8 * (s) + 3], (x)[8 * (s) + 4], (x)[8 * (s) + 5], (x)[8 * (s) + 6], (x)[8 * (s) + 7])
typedef short v4i16_t __attribute__((ext_vector_type(4)));
__device__ __forceinline__ s16x4 trd(const LAS unsigned char* p) { return __builtin_bit_cast(s16x4, __builtin_amdgcn_ds_read_tr16_b64_v4i16((LAS v4i16_t*)p)); }
__device__ __forceinline__ bf16x8 trfrag(const LAS unsigned char* p, int stride8) { const s16x4 lo = trd(p), hi = trd(p + stride8); return __builtin_shufflevector(lo, hi, 0, 1, 2, 3, 4, 5, 6, 7); }
__device__ __forceinline__ float sigmoidf_(float x) { return __builtin_amdgcn_rcpf(1.0f + __expf(-x)); }
__device__ __forceinline__ float softplusf_(float z) { return fmaxf(z, 0.f) + __logf(1.0f + __expf(-fabsf(z))); }

__device__ __forceinline__ void transpose_item(const float* W, int Nsrc, bf16* WT, int ldw, int d0, int k0, int map, bool dup, LAS float* scr, int lane) {
    const int d = d0 + (lane & 31); int sc;
    if (map == 0) sc = d < 3072 ? d : (d < 8192 ? d + 16 : (d < 8208 ? 3072 + (d - 8192) : -1));
    else if (map == 1) { const int pn = d >> 8, j = d & 255; sc = j < 128 ? 128 * pn + j : FF + 128 * pn + (j - 128); }
    else sc = d;
#pragma unroll 8
    for (int i = 0; i < 32; ++i) { const int kk = 2 * i + (lane >> 5); scr[kk * 33 + (lane & 31)] = sc >= 0 ? W[(size_t)(k0 + kk) * Nsrc + sc] : 0.f; }
    asm volatile("s_waitcnt lgkmcnt(0)" ::: "memory");
    const int c = lane & 7;
#pragma unroll
    for (int j = 0; j < 4; ++j) { const int n = (lane >> 3) + 8 * j; const LAS float* s = scr + (8 * c) * 33 + n;
        v4u o; o.x = cvtpk(s[0 * 33], s[1 * 33]); o.y = cvtpk(s[2 * 33], s[3 * 33]); o.z = cvtpk(s[4 * 33], s[5 * 33]); o.w = cvtpk(s[6 * 33], s[7 * 33]);
        bf16* dst = WT + (size_t)(d0 + n) * ldw + k0 + 8 * c; *(v4u*)dst = o; if (dup) *(v4u*)(dst + 1024) = o; }
    asm volatile("s_waitcnt lgkmcnt(0)" ::: "memory");
}

struct Args { const float* in[15]; float* out; unsigned char* ws; };

__device__ __forceinline__ void row_stats(f32x4 (&v)[4], float& rstd) {
    float s = 0.f;
#pragma unroll
    for (int j = 0; j < 4; ++j) s += (v[j].x + v[j].y) + (v[j].z + v[j].w);
    const float mean = wave_sum(s) * (1.f / D); float s2 = 0.f;
#pragma unroll
    for (int j = 0; j < 4; ++j) { v[j] = v[j] - mean; s2 += (v[j].x * v[j].x + v[j].y * v[j].y) + (v[j].z * v[j].z + v[j].w * v[j].w); }
    rstd = 1.0f / sqrtf(wave_sum(s2) * (1.f / D) + LN_EPS);
}

constexpr int SB_KS = 272;
__device__ __forceinline__ void sb_unit(bf16* H, LAS unsigned char* wl, int b, int hd, int qt, int lane) {
    const int n = lane & 31, hh = lane >> 5, i16 = lane & 15, tq = i16 >> 2, tp = i16 & 3, blk = (lane >> 4) & 1;
    const size_t rowbase = (size_t)b * SEQ;
    bf16x8 qf[8];
    { const bf16* qp = H + (rowbase + 32 * qt + n) * HW + C_SQ + hd * 128 + 8 * hh;
#pragma unroll
      for (int s = 0; s < 8; ++s) qf[s] = *(const bf16x8*)(qp + 16 * s); }
    f32x16 oT[4];
#pragma unroll
    for (int cb = 0; cb < 4; ++cb)
#pragma unroll
        for (int r = 0; r < 16; ++r) oT[cb][r] = 0.f;
    float R = 0.f;
    LAS unsigned char* Kl = wl; LAS unsigned char* Vl = wl + 32 * SB_KS;
    const LAS unsigned char* kread = Kl + n * SB_KS + 16 * hh;
    const LAS unsigned char* vread = Vl + (4 * hh + tq) * SB_KS + (16 * blk + 4 * tp) * 2;
    for (int kt = qt; kt >= 0; --kt) {
        const bf16* kp = H + (rowbase + 32 * kt) * HW + C_SK + hd * 128;
        const bf16* vp = H + (rowbase + 32 * kt) * HW + C_SV + hd * 128;
#pragma unroll
        for (int i = 0; i < 8; ++i) { const int id = lane + 64 * i, row = id >> 4, ch = id & 15;
            const v4u kv = *(const v4u*)(kp + (size_t)row * HW + ch * 8); const v4u vv = *(const v4u*)(vp + (size_t)row * HW + ch * 8);
            *(LAS v4u*)(Kl + row * SB_KS + ch * 16) = kv; *(LAS v4u*)(Vl + row * SB_KS + ch * 16) = vv; }
        asm volatile("s_waitcnt lgkmcnt(0)" ::: "memory");
        f32x16 st;
#pragma unroll
        for (int r = 0; r < 16; ++r) st[r] = 0.f;
#pragma unroll
        for (int s = 0; s < 8; ++s) { const bf16x8 kf = *(const LAS bf16x8*)(kread + 32 * s); st = MFMA32(kf, qf[s], st); }
        const bool diag = (kt == qt);
        float sp[16], la[16], ex[16];
#pragma unroll
        for (int r = 0; r < 16; ++r) { const float z = st[r] * QK_SCALE; const float spv = softplusf_(z); const bool valid = !diag || (crow(r, hh) < n);
            sp[r] = valid ? spv : 0.f; la[r] = valid ? (z - spv) : -1.0e30f; }
        float own[4], par[4];
#pragma unroll
        for (int g = 0; g < 4; ++g) { ex[4 * g + 3] = 0.f; ex[4 * g + 2] = sp[4 * g + 3]; ex[4 * g + 1] = ex[4 * g + 2] + sp[4 * g + 2]; ex[4 * g] = ex[4 * g + 1] + sp[4 * g + 1]; own[g] = ex[4 * g] + sp[4 * g]; }
#pragma unroll
        for (int g = 0; g < 4; ++g) par[g] = __shfl_xor(own[g], 32);
        float U[4];
        U[3] = 0.f; U[2] = own[3] + par[3]; U[1] = U[2] + (own[2] + par[2]); U[0] = U[1] + (own[1] + par[1]);
        const float total = U[0] + (own[0] + par[0]);
        float w[16];
#pragma unroll
        for (int r = 0; r < 16; ++r) { const int g = r >> 2; const float after = R + U[g] + (hh == 0 ? par[g] : 0.f) + ex[r]; w[r] = __expf(la[r] - after); }
        R += total;
        const bf16x8 wf0 = pack8(w[0], w[1], w[2], w[3], w[4], w[5], w[6], w[7]), wf1 = pack8(w[8], w[9], w[10], w[11], w[12], w[13], w[14], w[15]);
#pragma unroll
        for (int cb = 0; cb < 4; ++cb) {
            const bf16x8 v0 = trfrag(vread + 64 * cb, 8 * SB_KS), v1 = trfrag(vread + 16 * SB_KS + 64 * cb, 8 * SB_KS);
            oT[cb] = MFMA32(v0, wf0, oT[cb]); oT[cb] = MFMA32(v1, wf1, oT[cb]); }
        asm volatile("s_waitcnt lgkmcnt(0)" ::: "memory");
        if (__ballot(R <= 104.0f) == 0ull) break;
    }
    const size_t mrow = (rowbase + 32 * qt + n) * HW;
#pragma unroll
    for (int cb = 0; cb < 4; ++cb)
#pragma unroll
        for (int g = 0; g < 4; ++g) { const int dh0 = hd * 128 + 32 * cb + 8 * g + 4 * hh;
            const v2u mb = *(const v2u*)(H + mrow + C_MB + dh0);
            const float g0 = sigmoidf_(__uint_as_float(mb.x << 16)), g1 = sigmoidf_(__uint_as_float(mb.x & 0xffff0000u)), g2 = sigmoidf_(__uint_as_float(mb.y << 16)), g3 = sigmoidf_(__uint_as_float(mb.y & 0xffff0000u));
            v2u o; o.x = cvtpk(oT[cb][4 * g] * g0, oT[cb][4 * g + 1] * g1); o.y = cvtpk(oT[cb][4 * g + 2] * g2, oT[cb][4 * g + 3] * g3);
            *(v2u*)(H + mrow + C_SQ + dh0) = o; }
}
constexpr int GL_QS = 272, GL_VS = 528;
constexpr int GL_QE = 0, GL_KE = 64 * GL_QS, GL_KD = 2 * 64 * GL_QS, GL_VV = 3 * 64 * GL_QS, GL_GA = GL_VV + 64 * GL_VS, GL_SEG = GL_GA + 4096, GL_EB = GL_SEG + 2048, GL_SSQ = GL_EB + 512, GL_END = GL_SSQ + 2048;
static_assert(GL_END <= 131072, "GLA LDS map");
__device__ __forceinline__ void gla_unit(bf16* H, const bf16* GA, const float* w_up, const float* b_alpha, const float* gng, LAS unsigned char* lds, int b, int hg, int tid) {
    const int lane = tid & 63, wave = tid >> 6, n = lane & 31, hh = lane >> 5, i16 = lane & 15, tq = i16 >> 2, tp = i16 & 3, blk = (lane >> 4) & 1;
    const int d = tid & 127, seg = tid >> 7;
    float wup[16];
#pragma unroll
    for (int r = 0; r < 16; ++r) wup[r] = w_up[r * 512 + hg * 128 + d];
    const float bal = b_alpha[hg * 128 + d];
    f32x16 sacc[4];
#pragma unroll
    for (int db = 0; db < 4; ++db)
#pragma unroll
        for (int r = 0; r < 16; ++r) sacc[db][r] = 0.f;
    LAS float* GAc = (LAS float*)(lds + GL_GA); LAS float* SEG = (LAS float*)(lds + GL_SEG); LAS float* EB = (LAS float*)(lds + GL_EB); LAS float* SSQ = (LAS float*)(lds + GL_SSQ);
    const LAS unsigned char* vtr_base = lds + GL_VV + (4 * hh + tq) * GL_VS + (32 * wave + 16 * blk + 4 * tp) * 2;
    const LAS unsigned char* kdtr_base = lds + GL_KD + (4 * hh + tq) * GL_QS + (16 * blk + 4 * tp) * 2;
    for (int c = 0; c < SEQ / 64; ++c) {
        const size_t m0 = (size_t)b * SEQ + 64 * c;
        unsigned short qraw[16], kraw[16];
#pragma unroll
        for (int ii = 0; ii < 16; ++ii) { const bf16* rp = H + (m0 + 16 * seg + ii) * HW + hg * 128 + d; qraw[ii] = rp[C_GQ]; kraw[ii] = rp[C_GK]; }
#pragma unroll
        for (int e = tid; e < 1024; e += NTHR) GAc[e] = bf2f(GA[m0 * 16 + e]);
#pragma unroll
        for (int i = 0; i < 4; ++i) { const int id = tid + NTHR * i, row = id >> 5, ch = id & 31;
            *(LAS v4u*)(lds + GL_VV + row * GL_VS + ch * 16) = *(const v4u*)(H + (m0 + row) * HW + C_GV + hg * 256 + ch * 8); }
        __syncthreads();
        float bb[16]; float run = 0.f;
#pragma unroll
        for (int ii = 0; ii < 16; ++ii) { const LAS f32x4* g4 = (const LAS f32x4*)(GAc + (16 * seg + ii) * 16); float z = bal;
#pragma unroll
            for (int r4 = 0; r4 < 4; ++r4) { const f32x4 gv = g4[r4]; z += gv.x * wup[4 * r4] + gv.y * wup[4 * r4 + 1] + gv.z * wup[4 * r4 + 2] + gv.w * wup[4 * r4 + 3]; }
            run += -softplusf_(-z) * (1.0f / 16.0f); bb[ii] = run; }
        SEG[seg * 128 + d] = run;
        __syncthreads();
        { const float t0 = SEG[d], t1 = SEG[128 + d], t2 = SEG[256 + d], t3 = SEG[384 + d];
          const float off = (seg > 0 ? t0 : 0.f) + (seg > 1 ? t1 : 0.f) + (seg > 2 ? t2 : 0.f); const float blast = ((t0 + t1) + t2) + t3;
          if (seg == 0) EB[d] = __expf(blast);
#pragma unroll
          for (int ii = 0; ii < 16; ++ii) { const int i = 16 * seg + ii; const float bi = bb[ii] + off; const float qv = bf2f(qraw[ii]), kv = bf2f(kraw[ii]);
              *(LAS unsigned short*)(lds + GL_QE + i * GL_QS + d * 2) = (unsigned short)(cvtpk(qv * QK_SCALE * __expf(bi), 0.f) & 0xffffu);
              *(LAS unsigned short*)(lds + GL_KE + i * GL_QS + d * 2) = (unsigned short)(cvtpk(kv * __expf(-bi), 0.f) & 0xffffu);
              *(LAS unsigned short*)(lds + GL_KD + i * GL_QS + d * 2) = (unsigned short)(cvtpk(kv * __expf(blast - bi), 0.f) & 0xffffu); } }
        __syncthreads();
        f32x16 oT[2];
#pragma unroll
        for (int tb = 0; tb < 2; ++tb)
#pragma unroll
            for (int r = 0; r < 16; ++r) oT[tb][r] = 0.f;
#pragma unroll
        for (int db = 0; db < 4; ++db)
#pragma unroll
            for (int s = 0; s < 2; ++s) { const bf16x8 sf = PACK_STEP(sacc[db], s);
#pragma unroll
                for (int tb = 0; tb < 2; ++tb) { const LAS unsigned char* qb = lds + GL_QE + (32 * tb + n) * GL_QS + (32 * db + 16 * s + 4 * hh) * 2;
                    const s16x4 lo = *(const LAS s16x4*)qb, hi = *(const LAS s16x4*)(qb + 16); const bf16x8 bq = __builtin_shufflevector(lo, hi, 0, 1, 2, 3, 4, 5, 6, 7);
                    oT[tb] = MFMA32(sf, bq, oT[tb]); } }
        bf16x8 vf[2][2];
#pragma unroll
        for (int sb = 0; sb < 2; ++sb)
#pragma unroll
            for (int s2 = 0; s2 < 2; ++s2) vf[sb][s2] = trfrag(vtr_base + (32 * sb + 16 * s2) * GL_VS, 8 * GL_VS);
#pragma unroll
        for (int blk3 = 0; blk3 < 3; ++blk3) { const int sb = blk3 >> 1, tb = (blk3 + 1) >> 1;
            f32x16 pt;
#pragma unroll
            for (int r = 0; r < 16; ++r) pt[r] = 0.f;
#pragma unroll
            for (int ks = 0; ks < 8; ++ks) { const bf16x8 ka = *(const LAS bf16x8*)(lds + GL_KE + (32 * sb + n) * GL_QS + (16 * ks + 8 * hh) * 2);
                const bf16x8 qb = *(const LAS bf16x8*)(lds + GL_QE + (32 * tb + n) * GL_QS + (16 * ks + 8 * hh) * 2); pt = MFMA32(ka, qb, pt); }
            if (sb == tb) {
#pragma unroll
                for (int r = 0; r < 16; ++r) pt[r] = (crow(r, hh) <= n) ? pt[r] : 0.f; }
            const bf16x8 p0 = PACK_STEP(pt, 0), p1 = PACK_STEP(pt, 1);
            oT[tb] = MFMA32(vf[sb][0], p0, oT[tb]); oT[tb] = MFMA32(vf[sb][1], p1, oT[tb]); }
#pragma unroll
        for (int db = 0; db < 4; ++db) {
#pragma unroll
            for (int g = 0; g < 4; ++g) { const f32x4 e4 = *(const LAS f32x4*)(EB + 32 * db + 8 * g + 4 * hh);
                sacc[db][4 * g] *= e4.x; sacc[db][4 * g + 1] *= e4.y; sacc[db][4 * g + 2] *= e4.z; sacc[db][4 * g + 3] *= e4.w; }
#pragma unroll
            for (int sb = 0; sb < 2; ++sb)
#pragma unroll
                for (int s2 = 0; s2 < 2; ++s2) { const bf16x8 kdf = trfrag(kdtr_base + (32 * sb + 16 * s2) * GL_QS + 64 * db, 8 * GL_QS); sacc[db] = MFMA32(kdf, vf[sb][s2], sacc[db]); } }
#pragma unroll
        for (int tb = 0; tb < 2; ++tb) { float ss = 0.f;
#pragma unroll
            for (int r = 0; r < 16; ++r) ss += oT[tb][r] * oT[tb][r];
            ss += __shfl_xor(ss, 32); if (hh == 0) SSQ[wave * 64 + 32 * tb + n] = ss; }
        __syncthreads();
#pragma unroll
        for (int tb = 0; tb < 2; ++tb) { const int t = 32 * tb + n; float tot = 0.f;
#pragma unroll
            for (int w8 = 0; w8 < 8; ++w8) tot += SSQ[w8 * 64 + t];
            const float rstd = 1.0f / sqrtf(tot * (1.0f / 256.0f) + LN_EPS); bf16* rowp = H + (m0 + t) * HW;
#pragma unroll
            for (int g = 0; g < 4; ++g) { const int col = hg * 256 + 32 * wave + 8 * g + 4 * hh;
                const v2u gg = *(const v2u*)(rowp + C_GG + col), ma = *(const v2u*)(rowp + C_MA + col); const f32x4 gn = *(const f32x4*)(gng + col);
                const float x0 = __uint_as_float(gg.x << 16), x1 = __uint_as_float(gg.x & 0xffff0000u), x2 = __uint_as_float(gg.y << 16), x3 = __uint_as_float(gg.y & 0xffff0000u);
                const float a0 = __uint_as_float(ma.x << 16), a1 = __uint_as_float(ma.x & 0xffff0000u), a2 = __uint_as_float(ma.y << 16), a3 = __uint_as_float(ma.y & 0xffff0000u);
                const float o0 = oT[tb][4 * g] * rstd * gn.x * (x0 * sigmoidf_(x0)) * sigmoidf_(a0), o1 = oT[tb][4 * g + 1] * rstd * gn.y * (x1 * sigmoidf_(x1)) * sigmoidf_(a1);
                const float o2 = oT[tb][4 * g + 2] * rstd * gn.z * (x2 * sigmoidf_(x2)) * sigmoidf_(a2), o3 = oT[tb][4 * g + 3] * rstd * gn.w * (x3 * sigmoidf_(x3)) * sigmoidf_(a3);
                v2u o; o.x = cvtpk(o0, o1); o.y = cvtpk(o2, o3); *(v2u*)(rowp + C_GG + col) = o; } }
    }
}
__global__ void __launch_bounds__(NTHR, 2) fwd_megakernel(Args args) {
    extern __shared__ __attribute__((aligned(16))) unsigned char lds_raw[];
    cg::grid_group grid = cg::this_grid();
    LAS unsigned char* lds = (LAS unsigned char*)lds_raw;
    const int tid = threadIdx.x, lane = tid & 63, wave = __builtin_amdgcn_readfirstlane(tid >> 6);
    const int G = gridDim.x, bx = blockIdx.x;
    const float* x = args.in[0]; const float* cvec = args.in[1]; const float* w_ada = args.in[2]; const float* b_ada = args.in[3]; const float* w_in = args.in[4];
    const float* w_up = args.in[5]; const float* b_alpha = args.in[6]; const float* gng = args.in[7]; const float* w_out = args.in[8];
    const float* ln1_g = args.in[9]; const float* ln1_b = args.in[10]; const float* w_ffin = args.in[11]; const float* w_ffout = args.in[12]; const float* ln2_g = args.in[13]; const float* ln2_b = args.in[14];
    unsigned char* dsc = (unsigned char*)args.out;
    bf16* H = (bf16*)args.ws; float* Hf = (float*)args.ws;
    bf16* U1 = (bf16*)(dsc + DO_U1); bf16* Wt_in = (bf16*)(dsc + DO_WIN); bf16* Wt_out = (bf16*)(dsc + DO_WOUT); bf16* Wt_ffin = (bf16*)(dsc + DO_WFFIN); bf16* Wt_ffout = (bf16*)(dsc + DO_WFFOUT);
    bf16* GA = (bf16*)(dsc + DO_GA); float* modp = (float*)(dsc + DO_MODP); float* modf = (float*)(dsc + DO_MODF);

    {
        LAS float* scr = (LAS float*)(lds + wave * 16384);
        const int gw = bx * NWAVES + wave, NGW = G * NWAVES;
        constexpr int I_ADA = 96 * 16, I_IN = (NIN / 32) * (D / 64), I_OUT = (D / 32) * (D / 64), I_FI = (2 * FF / 32) * (D / 64), I_FO = (D / 32) * (FF / 64);
        constexpr int NITEMS = I_ADA + I_IN + I_OUT + I_FI + I_FO;
        for (int it = gw; it < NITEMS; it += NGW) {
            int r = it;
            if (r < I_ADA) {
                const int cgp = r % 96, ks = r / 96, col = 64 * cgp + lane, k0 = 64 * ks;
                float sc[8], acc[8];
#pragma unroll
                for (int b = 0; b < 8; ++b) { const float cv = cvec[b * D + k0 + lane]; sc[b] = cv * sigmoidf_(cv); acc[b] = 0.f; }
#pragma unroll 8
                for (int kk = 0; kk < 64; ++kk) { const float w = w_ada[(size_t)(k0 + kk) * NMOD + col];
#pragma unroll
                    for (int b = 0; b < 8; ++b) acc[b] += __shfl(sc[b], kk) * w; }
#pragma unroll
                for (int b = 0; b < 8; ++b) modp[(size_t)(ks * 8 + b) * NMOD + col] = acc[b];
                continue;
            }
            r -= I_ADA;
            if (r < I_IN) { transpose_item(w_in, 8208, Wt_in, D, 32 * (r % (NIN / 32)), 64 * (r / (NIN / 32)), 0, false, scr, lane); continue; } r -= I_IN;
            if (r < I_OUT) { transpose_item(w_out, D, Wt_out, 2048, 32 * (r % (D / 32)), 64 * (r / (D / 32)), 2, true, scr, lane); continue; } r -= I_OUT;
            if (r < I_FI) { transpose_item(w_ffin, 2 * FF, Wt_ffin, D, 32 * (r % (2 * FF / 32)), 64 * (r / (2 * FF / 32)), 1, false, scr, lane); continue; } r -= I_FI;
            transpose_item(w_ffout, D, Wt_ffout, FF, 32 * (r % (D / 32)), 64 * (r / (D / 32)), 2, false, scr, lane);
        }
    }
    grid.sync();

    {
        for (int idx = bx * NTHR + tid; idx < BATCH * NMOD; idx += G * NTHR) { const int b = idx / NMOD, j = idx % NMOD; float s = b_ada[j];
#pragma unroll
            for (int ks = 0; ks < 16; ++ks) s += modp[(size_t)(ks * 8 + b) * NMOD + j];
            modf[idx] = s; }
        LAS float* ssh = (LAS float*)lds; LAS float* ssc = ssh + D;
        for (int rg = bx; rg < M / 128; rg += G) {
            const int b = rg / (SEQ / 128);
            __syncthreads();
            for (int j = tid; j < 2 * D; j += NTHR) { float s = b_ada[j];
#pragma unroll
                for (int ks = 0; ks < 16; ++ks) s += modp[(size_t)(ks * 8 + b) * NMOD + j];
                ssh[j] = s; }
            __syncthreads();
            for (int i = 0; i < 16; ++i) { const size_t row = (size_t)rg * 128 + wave * 16 + i;
                const f32x4* xr = (const f32x4*)(x + row * D) + lane; f32x4 v[4];
#pragma unroll
                for (int j = 0; j < 4; ++j) v[j] = xr[64 * j];
                float rstd; row_stats(v, rstd);
                unsigned long long* o8 = (unsigned long long*)(U1 + row * D) + lane;
#pragma unroll
                for (int j = 0; j < 4; ++j) { const int c0 = 4 * lane + 256 * j; const f32x4 sc = *(const LAS f32x4*)(ssc + c0), sh = *(const LAS f32x4*)(ssh + c0);
                    const f32x4 o = v[j] * rstd * (sc + 1.0f) + sh; o8[64 * j] = (unsigned long long)cvtpk(o.x, o.y) | ((unsigned long long)cvtpk(o.z, o.w) << 32); } }
        }
    }
    grid.sync();

    { pg8::Gemm g{U1, Wt_in, M, NIN, D, D}; pg8::StaticOrder S; S.init(M, NIN, G, bx); pg8::EpiH E{H, GA};
      pg8::gemm_phase<pg8::EpiH, pg8::StaticOrder, PG8_ALIGN, PG8_SP2>(lds, g, S, E); }
    grid.sync();

    {
        const int NGLA = BATCH * 4;
        if (bx < NGLA) { gla_unit(H, GA, w_up, b_alpha, gng, lds, bx >> 2, bx & 3, tid); }
        else if (G > NGLA) {
            LAS unsigned char* wl = lds + wave * (64 * SB_KS);
            const int NSBW = (G - NGLA) * NWAVES;
            for (int u = (bx - NGLA) * NWAVES + wave; u < BATCH * 8 * (SEQ / 32); u += NSBW) { const int qt = u & 127, bh = u >> 7; sb_unit(H, wl, bh >> 3, bh & 7, qt, lane); }
        }
    }
    grid.sync();

    { pg8::Gemm g{H + C_GG, Wt_out, M, D, 2048, HW}; pg8::StaticOrder S; S.init(M, D, G, bx); pg8::EpiRes E{x, D, Hf + F_R, HROWF, modf + 2 * D, ALPHA};
      pg8::gemm_phase<pg8::EpiRes, pg8::StaticOrder, PG8_ALIGN, PG8_SP2>(lds, g, S, E); }
    grid.sync();

    {
        LAS float* sg = (LAS float*)lds; LAS float* sb_ = sg + D; LAS float* ssh = sb_ + D; LAS float* ssc = ssh + D;
        for (int rg = bx; rg < M / 128; rg += G) {
            const int b = rg / (SEQ / 128);
            __syncthreads();
            for (int j = tid; j < D; j += NTHR) { sg[j] = ln1_g[j]; sb_[j] = ln1_b[j]; ssh[j] = modf[(size_t)b * NMOD + 3 * D + j]; ssc[j] = modf[(size_t)b * NMOD + 4 * D + j]; }
            __syncthreads();
            for (int i = 0; i < 16; ++i) { const size_t row = (size_t)rg * 128 + wave * 16 + i;
                const f32x4* rr = (const f32x4*)(Hf + row * HROWF + F_R) + lane; f32x4 v[4];
#pragma unroll
                for (int j = 0; j < 4; ++j) v[j] = rr[64 * j];
                float rstd; row_stats(v, rstd);
                f32x4* x1o = (f32x4*)(Hf + row * HROWF + F_X1) + lane;
#pragma unroll
                for (int j = 0; j < 4; ++j) { const int c0 = 4 * lane + 256 * j; v[j] = v[j] * rstd * *(const LAS f32x4*)(sg + c0) + *(const LAS f32x4*)(sb_ + c0); x1o[64 * j] = v[j]; }
                row_stats(v, rstd);
                unsigned long long* o8 = (unsigned long long*)(H + row * HW + C_U2) + lane;
#pragma unroll
                for (int j = 0; j < 4; ++j) { const int c0 = 4 * lane + 256 * j; const f32x4 o = v[j] * rstd * (*(const LAS f32x4*)(ssc + c0) + 1.0f) + *(const LAS f32x4*)(ssh + c0);
                    o8[64 * j] = (unsigned long long)cvtpk(o.x, o.y) | ((unsigned long long)cvtpk(o.z, o.w) << 32); } }
        }
    }
    grid.sync();

    { pg8::Gemm g{H + C_U2, Wt_ffin, M, 2 * FF, D, HW}; pg8::StaticOrder S; S.init(M, 2 * FF, G, bx); pg8::EpiSwiglu E{H + C_ACT, HW};
      pg8::gemm_phase<pg8::EpiSwiglu, pg8::StaticOrder, PG8_ALIGN, PG8_SP2>(lds, g, S, E); }
    grid.sync();

    { pg8::Gemm g{H + C_ACT, Wt_ffout, M, D, FF, HW}; pg8::StaticOrder S; S.init(M, D, G, bx); pg8::EpiRes E{Hf + F_X1, HROWF, Hf + F_R, HROWF, modf + 5 * D, ALPHA};
      pg8::gemm_phase<pg8::EpiRes, pg8::StaticOrder, PG8_ALIGN, PG8_SP2>(lds, g, S, E); }
    grid.sync();

    {
        for (size_t row = (size_t)bx * NWAVES + wave; row < (size_t)M; row += (size_t)G * NWAVES) {
            const f32x4* rr = (const f32x4*)(Hf + row * HROWF + F_R) + lane; f32x4 v[4];
#pragma unroll
            for (int j = 0; j < 4; ++j) v[j] = rr[64 * j];
            float rstd; row_stats(v, rstd);
            f32x4* oo = (f32x4*)(args.out + row * D) + lane;
#pragma unroll
            for (int j = 0; j < 4; ++j) { const int c0 = 4 * lane + 256 * j; oo[64 * j] = v[j] * rstd * *(const f32x4*)(ln2_g + c0) + *(const f32x4*)(ln2_b + c0); }
        }
    }
}

extern "C" void kernel_launch(void* const* d_in, const int* in_sizes, int n_in, void* d_out, int out_size, void* d_ws, size_t ws_size, hipStream_t stream) {
    static int grid = 0;
    if (grid == 0) {
        if (n_in != 15 || out_size != M * D || ws_size < (size_t)M * HW * 2) { fprintf(stderr, "kernel_launch: unexpected problem shape (n_in %d, out %d, ws %zu)\n", n_in, out_size, ws_size); grid = -1; return; }
        int dev = 0, cus = 0, per_cu = 0;
        if (hipGetDevice(&dev) != hipSuccess || hipDeviceGetAttribute(&cus, hipDeviceAttributeMultiprocessorCount, dev) != hipSuccess) { grid = -1; return; }
        if (hipFuncSetAttribute((const void*)fwd_megakernel, hipFuncAttributeMaxDynamicSharedMemorySize, LDS_BYTES) != hipSuccess) { fprintf(stderr, "kernel_launch: hipFuncSetAttribute failed\n"); grid = -1; return; }
        if (hipOccupancyMaxActiveBlocksPerMultiprocessor(&per_cu, (const void*)fwd_megakernel, NTHR, LDS_BYTES) != hipSuccess || per_cu < 1) { fprintf(stderr, "kernel_launch: occupancy query gave %d\n", per_cu); per_cu = 1; }
        (void)hipGetLastError();
        grid = cus * per_cu;
    }
    if (grid < 0) return;
    Args a{};
    for (int i = 0; i < 15; ++i) a.in[i] = (const float*)d_in[i];
    a.out = (float*)d_out; a.ws = (unsigned char*)d_ws;
    void* kargs[] = {&a};
    const hipError_t e = hipLaunchCooperativeKernel((const void*)fwd_megakernel, dim3(grid), dim3(NTHR), kargs, LDS_BYTES, stream);
    if (e != hipSuccess) fprintf(stderr, "kernel_launch: cooperative launch failed: %s (grid %d)\n", hipGetErrorString(e), grid);
}
```

```cpp
#include <hip/hip_runtime.h>
#include <hip/hip_cooperative_groups.h>
#include <cstdio>
#include <cstdint>
namespace cg = cooperative_groups;
namespace pg8 {
#define PG8_LAS __attribute__((address_space(3)))
typedef unsigned short bf16_t;
typedef short bf16x8 __attribute__((ext_vector_type(8)));
typedef float f32x4 __attribute__((ext_vector_type(4)));
typedef unsigned u32x4 __attribute__((ext_vector_type(4)));
constexpr int BM = 256, BK = 64, HALF = 128, HTB = HALF * BK * 2  , STAGE_BYTES = 8 * HTB, NXCD = 8, WGM = 8;

__host__ __device__ __forceinline__ int lds_byte(int r, int c) { const int st = (r >> 4) * 2 + (c >> 5), rr = r & 15, cc = c & 31, ob = rr * 64 + cc * 2; return st * 1024 + (ob ^ (((ob >> 9) & 1) << 5)); }
__host__ __device__ __forceinline__ void stage_rc(int b, int& R, int& C) { const int st = b / 1024, sb = b % 1024, swz = sb ^ (((sb >> 9) & 1) << 5); R = (st >> 1) * 16 + swz / 64; C = (st & 1) * 32 + (swz % 64) / 2; }
__host__ __device__ __forceinline__ int perm32(int rho) { const int n = rho >> 4, i = rho & 15; return 8 * (i >> 2) + 4 * n + (i & 3); }

struct Unit { int pm, pn; };
struct Gemm { const bf16_t* A; const bf16_t* Bt; int M, N, K, lda; };

struct StaticOrder {
    int nM, nN, nwg, G, c;
    __host__ __device__ void init(int M, int N, int G_, int c_) { nM = M / BM; nN = N / BM; nwg = nM * nN; G = G_; c = c_; }
    __host__ __device__ bool next(int i, Unit& u) const {
        const long L = (long)i * G + c; if (L >= nwg) return false;
        int wgid = (int)L; { const int q = nwg / NXCD, r = nwg % NXCD, xcd = wgid % NXCD, off = wgid / NXCD; wgid = (xcd < r ? xcd * (q + 1) : r * (q + 1) + (xcd - r) * q) + off; }
        const int nig = WGM * nN, gid = wgid / nig, fm = gid * WGM, gsz = (nM - fm) < WGM ? (nM - fm) : WGM;
        u.pm = fm + ((wgid % nig) % gsz); u.pn = (wgid % nig) / gsz; return true;
    }
    __device__ __forceinline__ void a_ready(const Unit&) const {}
    __device__ __forceinline__ void done(const Unit&) const {}
};

__device__ __forceinline__ unsigned cvt_pk_bf16(float lo, float hi) { unsigned r; asm volatile("v_cvt_pk_bf16_f32 %0, %1, %2" : "=v"(r) : "v"(lo), "v"(hi)); return r; }
typedef __bf16 bf16x2_t __attribute__((ext_vector_type(2)));
typedef float f32x2_t __attribute__((ext_vector_type(2)));
typedef unsigned u32x2 __attribute__((ext_vector_type(2)));
__device__ __forceinline__ unsigned cvtpk(float lo, float hi) { f32x2_t v = {lo, hi}; bf16x2_t b = __builtin_convertvector(v, bf16x2_t); return __builtin_bit_cast(unsigned, b); }

struct EpiH {
    static constexpr bool PERM = true, AFTER_DRAIN = false;
    bf16_t* H; bf16_t* GA;
    __device__ __forceinline__ void operator()(const f32x4 (&acc)[2][2][4][2], const Unit& u, int wr, int wc, int fr, int fq) const {
        const int row0 = u.pm * BM + wr * 64 + fr;
        if (u.pn < 32) {
            const int col0 = u.pn * BM + wc * 32 + 8 * fq;
#pragma unroll
            for (int ai = 0; ai < 2; ++ai)
#pragma unroll
                for (int m = 0; m < 4; ++m) { bf16_t* rowp = H + (size_t)(row0 + ai * HALF + m * 16) * 8192 + col0;
#pragma unroll
                    for (int bj = 0; bj < 2; ++bj) { const f32x4 v0 = acc[ai][bj][m][0], v1 = acc[ai][bj][m][1];
                        u32x4 w; w.x = cvtpk(v0[0], v0[1]); w.y = cvtpk(v0[2], v0[3]); w.z = cvtpk(v1[0], v1[1]); w.w = cvtpk(v1[2], v1[3]);
                        *(u32x4*)(rowp + bj * HALF) = w; } }
        } else if (wc == 0 && fq < 2) {
#pragma unroll
            for (int ai = 0; ai < 2; ++ai)
#pragma unroll
                for (int m = 0; m < 4; ++m) { const f32x4 v0 = acc[ai][0][m][0], v1 = acc[ai][0][m][1];
                    u32x4 w; w.x = cvtpk(v0[0], v0[1]); w.y = cvtpk(v0[2], v0[3]); w.z = cvtpk(v1[0], v1[1]); w.w = cvtpk(v1[2], v1[3]);
                    *(u32x4*)(GA + (size_t)(row0 + ai * HALF + m * 16) * 16 + 8 * fq) = w; }
        }
    }
};
struct EpiRes {
    static constexpr bool PERM = false, AFTER_DRAIN = false;
    const float* X; int ldx; float* O; int ldo; const float* gate; float alpha;
    __device__ __forceinline__ void operator()(const f32x4 (&acc)[2][2][4][2], const Unit& u, int wr, int wc, int fr, int fq) const {
        const int b = u.pm >> 4; const int col0 = u.pn * BM + wc * 32 + 4 * fq;
#pragma unroll
        for (int bj = 0; bj < 2; ++bj)
#pragma unroll
            for (int n = 0; n < 2; ++n) { const int c = col0 + bj * HALF + n * 16; const f32x4 gv = *(const f32x4*)(gate + (size_t)b * 6144 + c) + 1.0f;
#pragma unroll
                for (int ai = 0; ai < 2; ++ai)
#pragma unroll
                    for (int m = 0; m < 4; ++m) { const size_t r = (size_t)(u.pm * BM + ai * HALF + wr * 64 + m * 16 + fr);
                        const f32x4 xv = *(const f32x4*)(X + r * ldx + c); *(f32x4*)(O + r * ldo + c) = xv * alpha + gv * acc[ai][bj][m][n]; } }
    }
};
struct EpiSwiglu {
    static constexpr bool PERM = true, AFTER_DRAIN = false;
    bf16_t* O; int ldo;
    __device__ __forceinline__ void operator()(const f32x4 (&acc)[2][2][4][2], const Unit& u, int wr, int wc, int fr, int fq) const {
        const int row0 = u.pm * BM + wr * 64 + fr; const int col0 = u.pn * HALF + wc * 32 + 8 * fq;
#pragma unroll
        for (int ai = 0; ai < 2; ++ai)
#pragma unroll
            for (int m = 0; m < 4; ++m) { float a[8];
#pragma unroll
                for (int n = 0; n < 2; ++n)
#pragma unroll
                    for (int j = 0; j < 4; ++j) { const float g = acc[ai][0][m][n][j], up = acc[ai][1][m][n][j]; a[4 * n + j] = g * __builtin_amdgcn_rcpf(1.0f + __expf(-g)) * up; }
                u32x4 w; w.x = cvtpk(a[0], a[1]); w.y = cvtpk(a[2], a[3]); w.z = cvtpk(a[4], a[5]); w.w = cvtpk(a[6], a[7]);
                *(u32x4*)(O + (size_t)(row0 + ai * HALF + m * 16) * ldo + col0) = w; }
    }
};

template <class Epi, class Sched, bool ALIGN_EPI = false, bool SP2 = false>
__device__ __forceinline__ void gemm_phase(PG8_LAS unsigned char* lds, const Gemm g, const Sched& S, const Epi& E) {
    int tid_ = threadIdx.x; asm volatile("" : "+v"(tid_));
    const int tid = tid_, wid = __builtin_amdgcn_readfirstlane(tid >> 6), lane = tid & 63, wr = wid >> 2, wc = wid & 3, fr = lane & 15, fq = lane >> 4;
    const int K = g.K, nt = K / BK;
    unsigned voffA[2], voffB[2];
#pragma unroll
    for (int i = 0; i < 2; ++i) { int R, C; stage_rc(tid * 16 + i * 8192, R, C); const int Rb = Epi::PERM ? ((R & ~31) + perm32(R & 31)) : R;
        voffA[i] = (unsigned)(R * g.lda + C) * 2u; voffB[i] = (unsigned)(Rb * K + C) * 2u; }
    const size_t kstep = (size_t)(BK * 2);
    const size_t hstepA = (size_t)HALF * g.lda * 2, hstepB = (size_t)HALF * K * 2;
    const size_t tstepA = 2 * hstepA, tstepB = 2 * hstepB;
    const unsigned ldsw = (unsigned)wid * 1024u;
    const int aoff = lds_byte(wr * 64 + fr, fq * 8), boff = lds_byte(wc * 32 + fr, fq * 8);
#define PG8_SA(b, h) (((b) * 2 + (h)) * HTB)
#define PG8_SB(b, h) ((4 + (b) * 2 + (h)) * HTB)
#define PG8_STAGE(bufoff, gbase, voff) do { _Pragma("unroll") for (int _i = 0; _i < 2; ++_i) \
        __builtin_amdgcn_global_load_lds((const unsigned*)((const char*)(gbase) + (voff)[_i]), (PG8_LAS unsigned*)(lds + (bufoff) + ldsw + _i * 8192), 16, 0, 0); } while (0)
#define PG8_LDA(dst, b, h) do { _Pragma("unroll") for (int m = 0; m < 4; ++m) _Pragma("unroll") for (int k = 0; k < 2; ++k) dst[m][k] = *(const PG8_LAS bf16x8*)(lds + PG8_SA(b, h) + aoff + m * 2048 + k * 1024); } while (0)
#define PG8_LDB(dst, b, h) do { _Pragma("unroll") for (int n = 0; n < 2; ++n) _Pragma("unroll") for (int k = 0; k < 2; ++k) dst[n][k] = *(const PG8_LAS bf16x8*)(lds + PG8_SB(b, h) + boff + n * 2048 + k * 1024); } while (0)
#define PG8_MMA(ai, bj, At, Bt) do { __builtin_amdgcn_s_setprio(1); _Pragma("unroll") for (int m = 0; m < 4; ++m) _Pragma("unroll") for (int n = 0; n < 2; ++n) _Pragma("unroll") for (int k = 0; k < 2; ++k) \
        acc[ai][bj][m][n] = __builtin_amdgcn_mfma_f32_16x16x32_bf16(Bt[n][k], At[m][k], acc[ai][bj][m][n], 0, 0, 0); __builtin_amdgcn_s_setprio(0); } while (0)
#define PG8_WAIT_V(n) asm volatile("s_waitcnt vmcnt(" #n ")" ::: "memory")
#define PG8_WAIT_L(n) asm volatile("s_waitcnt lgkmcnt(" #n ")" ::: "memory")
#define PG8_BAR __builtin_amdgcn_s_barrier()
#define PG8_SCHED __builtin_amdgcn_sched_barrier(0)
    Unit cur, nxt; int ui = 0;
    if (!S.next(0, cur)) return;
    f32x4 acc[2][2][4][2];
#pragma unroll
    for (int a = 0; a < 2; ++a)
#pragma unroll
        for (int b = 0; b < 2; ++b)
#pragma unroll
            for (int m = 0; m < 4; ++m)
#pragma unroll
                for (int n = 0; n < 2; ++n) acc[a][b][m][n] = (f32x4){0.f, 0.f, 0.f, 0.f};
    bf16x8 At[4][2], B0[2][2], B1[2][2];
    const char* cA = (const char*)g.A + (size_t)cur.pm * tstepA; const char* cB = (const char*)g.Bt + (size_t)cur.pn * tstepB;
    S.a_ready(cur);
    if constexpr (SP2) {
        PG8_STAGE(PG8_SB(0, 0), cB, voffB); PG8_STAGE(PG8_SB(0, 1), cB + hstepB, voffB); PG8_STAGE(PG8_SA(0, 0), cA, voffA); PG8_STAGE(PG8_SA(0, 1), cA + hstepA, voffA);
        if (wr == 1) PG8_BAR;
        PG8_WAIT_V(2); PG8_BAR;
        PG8_STAGE(PG8_SB(1, 0), cB + kstep, voffB); PG8_STAGE(PG8_SA(1, 0), cA + kstep, voffA); PG8_STAGE(PG8_SB(1, 1), cB + hstepB + kstep, voffB);
        PG8_WAIT_V(6); PG8_BAR;
    } else {
        PG8_STAGE(PG8_SB(0, 0), cB, voffB); PG8_STAGE(PG8_SA(0, 0), cA, voffA); PG8_STAGE(PG8_SB(0, 1), cB + hstepB, voffB); PG8_STAGE(PG8_SA(0, 1), cA + hstepA, voffA);
        if (wr == 1) PG8_BAR;
        PG8_WAIT_V(4); PG8_BAR;
        PG8_STAGE(PG8_SB(1, 0), cB + kstep, voffB); PG8_STAGE(PG8_SA(1, 0), cA + kstep, voffA); PG8_STAGE(PG8_SB(1, 1), cB + hstepB + kstep, voffB);
        PG8_WAIT_V(6); PG8_BAR;
    }
    for (;;) {
        const bool has_next = S.next(ui + 1, nxt);
        const char* nA = has_next ? (const char*)g.A + (size_t)nxt.pm * tstepA : cA; const char* nB = has_next ? (const char*)g.Bt + (size_t)nxt.pn * tstepB : cB;
        for (int t = 0; t < nt; t += 2) {
            const bool last = (t == nt - 2);
            const char* a1 = cA + (size_t)(t + 1) * kstep;
            const char* a2 = last ? nA : cA + (size_t)(t + 2) * kstep; const char* b2 = last ? nB : cB + (size_t)(t + 2) * kstep;
            const char* a3 = a2 + kstep; const char* b3 = b2 + kstep;
            if (last && has_next) S.a_ready(nxt);
            if constexpr (SP2) {
            PG8_LDB(B0, 0, 0); PG8_LDB(B1, 0, 1); PG8_SCHED; PG8_LDA(At, 0, 0); PG8_STAGE(PG8_SA(1, 1), a1 + hstepA, voffA);
            PG8_WAIT_V(8); PG8_WAIT_L(0); PG8_BAR; PG8_MMA(0, 0, At, B0); PG8_MMA(0, 1, At, B1); PG8_BAR; PG8_SCHED;
            PG8_LDA(At, 0, 1); PG8_STAGE(PG8_SB(0, 0), b2, voffB); PG8_STAGE(PG8_SB(0, 1), b2 + hstepB, voffB); PG8_STAGE(PG8_SA(0, 0), a2, voffA);
            PG8_WAIT_V(8); PG8_WAIT_L(0); PG8_BAR; PG8_MMA(1, 0, At, B0); PG8_MMA(1, 1, At, B1); PG8_BAR; PG8_SCHED;
            PG8_LDB(B0, 1, 0); PG8_LDB(B1, 1, 1); PG8_SCHED; PG8_LDA(At, 1, 0); PG8_STAGE(PG8_SA(0, 1), a2 + hstepA, voffA);
            PG8_WAIT_V(8); PG8_WAIT_L(0); PG8_BAR; PG8_MMA(0, 0, At, B0); PG8_MMA(0, 1, At, B1); PG8_BAR; PG8_SCHED;
            PG8_LDA(At, 1, 1); PG8_STAGE(PG8_SB(1, 0), b3, voffB); PG8_STAGE(PG8_SB(1, 1), b3 + hstepB, voffB); PG8_STAGE(PG8_SA(1, 0), a3, voffA);
            PG8_WAIT_V(8); PG8_WAIT_L(0); PG8_BAR; PG8_MMA(1, 0, At, B0); PG8_MMA(1, 1, At, B1); PG8_BAR; PG8_SCHED;
            } else {
            PG8_LDB(B0, 0, 0); PG8_SCHED; PG8_LDA(At, 0, 0); PG8_STAGE(PG8_SA(1, 1), a1 + hstepA, voffA);
            PG8_WAIT_L(8); PG8_BAR; PG8_WAIT_L(0); PG8_MMA(0, 0, At, B0); PG8_BAR; PG8_SCHED;
            PG8_LDB(B1, 0, 1); PG8_STAGE(PG8_SB(0, 0), b2, voffB);
            PG8_BAR; PG8_WAIT_L(0); PG8_MMA(0, 1, At, B1); PG8_BAR;
            PG8_LDA(At, 0, 1); PG8_STAGE(PG8_SA(0, 0), a2, voffA);
            PG8_BAR; PG8_WAIT_L(0); PG8_MMA(1, 0, At, B0); PG8_BAR; PG8_SCHED;
            PG8_STAGE(PG8_SB(0, 1), b2 + hstepB, voffB);
            PG8_WAIT_V(6); PG8_BAR; PG8_MMA(1, 1, At, B1); PG8_BAR;
            PG8_LDB(B0, 1, 0); PG8_SCHED; PG8_LDA(At, 1, 0); PG8_STAGE(PG8_SA(0, 1), a2 + hstepA, voffA);
            PG8_WAIT_L(8); PG8_BAR; PG8_WAIT_L(0); PG8_MMA(0, 0, At, B0); PG8_BAR; PG8_SCHED;
            PG8_LDB(B1, 1, 1); PG8_STAGE(PG8_SB(1, 0), b3, voffB);
            PG8_BAR; PG8_WAIT_L(0); PG8_MMA(0, 1, At, B1); PG8_BAR;
            PG8_LDA(At, 1, 1); PG8_STAGE(PG8_SA(1, 0), a3, voffA);
            PG8_BAR; PG8_WAIT_L(0); PG8_MMA(1, 0, At, B0); PG8_BAR; PG8_SCHED;
            PG8_STAGE(PG8_SB(1, 1), b3 + hstepB, voffB);
            PG8_WAIT_V(6); PG8_BAR; PG8_MMA(1, 1, At, B1); PG8_BAR;
            }
        }
        if constexpr (ALIGN_EPI) { if (wr == 0) PG8_BAR; }
        if constexpr (!Epi::AFTER_DRAIN) { E(acc, cur, wr, wc, fr, fq); S.done(cur); }
        if (!has_next) break;
#pragma unroll
        for (int a = 0; a < 2; ++a)
#pragma unroll
            for (int b = 0; b < 2; ++b)
#pragma unroll
                for (int m = 0; m < 4; ++m)
#pragma unroll
                    for (int n = 0; n < 2; ++n) acc[a][b][m][n] = (f32x4){0.f, 0.f, 0.f, 0.f};
        cur = nxt; cA = nA; cB = nB; ++ui;
        if constexpr (ALIGN_EPI) { if (wr == 1) PG8_BAR; }
    }
    PG8_WAIT_V(0);
    if constexpr (!ALIGN_EPI) { if (wr == 0) PG8_BAR; }
    PG8_BAR;
    if constexpr (Epi::AFTER_DRAIN) { E.fused(acc, cur, wr, wc, fr, fq, lds, wid, lane); S.done(cur); }
#undef PG8_SA
#undef PG8_SB
#undef PG8_STAGE
#undef PG8_LDA
#undef PG8_LDB
#undef PG8_MMA
#undef PG8_WAIT_V
#undef PG8_WAIT_L
#undef PG8_BAR
#undef PG8_SCHED
}
}
#ifndef PG8_SP2
#define PG8_SP2 true
#endif
#ifndef PG8_ALIGN
#define PG8_ALIGN true
#endif
#define LAS __attribute__((address_space(3)))
typedef unsigned short bf16;
typedef short bf16x8 __attribute__((ext_vector_type(8)));
typedef short s16x4 __attribute__((ext_vector_type(4)));
typedef float f32x4 __attribute__((ext_vector_type(4)));
typedef float f32x16 __attribute__((ext_vector_type(16)));
typedef unsigned v4u __attribute__((ext_vector_type(4)));
typedef unsigned v2u __attribute__((ext_vector_type(2)));
using pg8::cvtpk;
constexpr int NWAVES = 8, NTHR = 512;
constexpr int BATCH = 8, SEQ = 4096, D = 1024, M = BATCH * SEQ, FF = 2816, NMOD = 6 * D;
constexpr int HW = 8192;
constexpr int C_GQ = 0, C_GK = 512, C_GV = 1024, C_GG = 2048, C_SQ = 3072, C_SK = 4096, C_SV = 5120, C_MA = 6144, C_MB = 7168;
constexpr int NIN = 8448;
constexpr int C_U2 = 0, C_ACT = 1024;
constexpr int HROWF = 4096, F_R = 2048, F_X1 = 3072;
constexpr float LN_EPS = 1e-5f, ALPHA = 1.189207115002721f;
constexpr float QK_SCALE = 0.08838834764831845f;
constexpr size_t MiB = 1u << 20;
constexpr size_t DO_U1 = 0, DO_WIN = 64 * MiB, DO_WOUT = 81 * MiB, DO_WFFIN = 85 * MiB, DO_WFFOUT = 96 * MiB, DO_GA = 102 * MiB, DO_MODP = 103 * MiB, DO_MODF = 106 * MiB;
static_assert(DO_WIN + (size_t)NIN * D * 2 <= DO_WOUT && DO_WOUT + (size_t)D * 2048 * 2 <= DO_WFFIN && DO_WFFIN + (size_t)2 * FF * D * 2 <= DO_WFFOUT && DO_WFFOUT + (size_t)D * FF * 2 <= DO_GA &&
              DO_GA + (size_t)M * 16 * 2 <= DO_MODP && DO_MODP + (size_t)16 * BATCH * NMOD * 4 <= DO_MODF && DO_MODF + (size_t)BATCH * NMOD * 4 <= 128 * MiB, "d_out scratch map");
constexpr int LDS_BYTES = 147456;

__device__ __forceinline__ float bf2f(unsigned short u) { return __uint_as_float((unsigned)u << 16); }
__device__ __forceinline__ float wave_sum(float v) {
#pragma unroll
    for (int o = 1; o < 64; o <<= 1) v += __shfl_xor(v, o);
    return v;
}
__device__ __forceinline__ int crow(int reg, int h) { return (reg & 3) + 8 * (reg >> 2) + 4 * h; }
#define MFMA32(a, b, c) __builtin_amdgcn_mfma_f32_32x32x16_bf16((a), (b), (c), 0, 0, 0)
__device__ __forceinline__ bf16x8 pack8(float a0, float a1, float a2, float a3, float a4, float a5, float a6, float a7) {
    v4u p; p.x = cvtpk(a0, a1); p.y = cvtpk(a2, a3); p.z = cvtpk(a4, a5); p.w = cvtpk(a6, a7); return __builtin_bit_cast(bf16x8, p);
}
#define PACK_STEP(x, s) pack8((x)[8 * (s)], (x)[8 * (s) + 1], (x)[8 * (s) + 2], (x)[8 * (s) + 3], (x)[8 * (s) + 4], (x)[8 * (s) + 5], (x)[8 * (s) + 6], (x)[8 * (s) + 7])
typedef short v4i16_t __attribute__((ext_vector_type(4)));
__device__ __forceinline__ s16x4 trd(const LAS unsigned char* p) { return __builtin_bit_cast(s16x4, __builtin_amdgcn_ds_read_tr16_b64_v4i16((LAS v4i16_t*)p)); }
__device__ __forceinline__ bf16x8 trfrag(const LAS unsigned char* p, int stride8) { const s16x4 lo = trd(p), hi = trd(p + stride8); return __builtin_shufflevector(lo, hi, 0, 1, 2, 3, 4, 5, 6, 7); }
__device__ __forceinline__ float sigmoidf_(float x) { return __builtin_amdgcn_rcpf(1.0f + __expf(-x)); }
__device__ __forceinline__ float softplusf_(float z) { return fmaxf(z, 0.f) + __logf(1.0f + __expf(-fabsf(z))); }

__device__ __forceinline__ void transpose_item(const float* W, int Nsrc, bf16* WT, int ldw, int d0, int k0, int map, bool dup, LAS float* scr, int lane) {
    const int d = d0 + (lane & 31); int sc;
    if (map == 0) sc = d < 3072 ? d : (d < 8192 ? d + 16 : (d < 8208 ? 3072 + (d - 8192) : -1));
    else if (map == 1) { const int pn = d >> 8, j = d & 255; sc = j < 128 ? 128 * pn + j : FF + 128 * pn + (j - 128); }
    else sc = d;
#pragma unroll 8
    for (int i = 0; i < 32; ++i) { const int kk = 2 * i + (lane >> 5); scr[kk * 33 + (lane & 31)] = sc >= 0 ? W[(size_t)(k0 + kk) * Nsrc + sc] : 0.f; }
    asm volatile("s_waitcnt lgkmcnt(0)" ::: "memory");
    const int c = lane & 7;
#pragma unroll
    for (int j = 0; j < 4; ++j) { const int n = (lane >> 3) + 8 * j; const LAS float* s = scr + (8 * c) * 33 + n;
        v4u o; o.x = cvtpk(s[0 * 33], s[1 * 33]); o.y = cvtpk(s[2 * 33], s[3 * 33]); o.z = cvtpk(s[4 * 33], s[5 * 33]); o.w = cvtpk(s[6 * 33], s[7 * 33]);
        bf16* dst = WT + (size_t)(d0 + n) * ldw + k0 + 8 * c; *(v4u*)dst = o; if (dup) *(v4u*)(dst + 1024) = o; }
    asm volatile("s_waitcnt lgkmcnt(0)" ::: "memory");
}

struct Args { const float* in[15]; float* out; unsigned char* ws; };

__device__ __forceinline__ void row_stats(f32x4 (&v)[4], float& rstd) {
    float s = 0.f;
#pragma unroll
    for (int j = 0; j < 4; ++j) s += (v[j].x + v[j].y) + (v[j].z + v[j].w);
    const float mean = wave_sum(s) * (1.f / D); float s2 = 0.f;
#pragma unroll
    for (int j = 0; j < 4; ++j) { v[j] = v[j] - mean; s2 += (v[j].x * v[j].x + v[j].y * v[j].y) + (v[j].z * v[j].z + v[j].w * v[j].w); }
    rstd = 1.0f / sqrtf(wave_sum(s2) * (1.f / D) + LN_EPS);
}

constexpr int SB_KS = 272;
__device__ __forceinline__ void sb_unit(bf16* H, LAS unsigned char* wl, int b, int hd, int qt, int lane) {
    const int n = lane & 31, hh = lane >> 5, i16 = lane & 15, tq = i16 >> 2, tp = i16 & 3, blk = (lane >> 4) & 1;
    const size_t rowbase = (size_t)b * SEQ;
    bf16x8 qf[8];
    { const bf16* qp = H + (rowbase + 32 * qt + n) * HW + C_SQ + hd * 128 + 8 * hh;
#pragma unroll
      for (int s = 0; s < 8; ++s) qf[s] = *(const bf16x8*)(qp + 16 * s); }
    f32x16 oT[4];
#pragma unroll
    for (int cb = 0; cb < 4; ++cb)
#pragma unroll
        for (int r = 0; r < 16; ++r) oT[cb][r] = 0.f;
    float R = 0.f;
    LAS unsigned char* Kl = wl; LAS unsigned char* Vl = wl + 32 * SB_KS;
    const LAS unsigned char* kread = Kl + n * SB_KS + 16 * hh;
    const LAS unsigned char* vread = Vl + (4 * hh + tq) * SB_KS + (16 * blk + 4 * tp) * 2;
    for (int kt = qt; kt >= 0; --kt) {
        const bf16* kp = H + (rowbase + 32 * kt) * HW + C_SK + hd * 128;
        const bf16* vp = H + (rowbase + 32 * kt) * HW + C_SV + hd * 128;
#pragma unroll
        for (int i = 0; i < 8; ++i) { const int id = lane + 64 * i, row = id >> 4, ch = id & 15;
            const v4u kv = *(const v4u*)(kp + (size_t)row * HW + ch * 8); const v4u vv = *(const v4u*)(vp + (size_t)row * HW + ch * 8);
            *(LAS v4u*)(Kl + row * SB_KS + ch * 16) = kv; *(LAS v4u*)(Vl + row * SB_KS + ch * 16) = vv; }
        asm volatile("s_waitcnt lgkmcnt(0)" ::: "memory");
        f32x16 st;
#pragma unroll
        for (int r = 0; r < 16; ++r) st[r] = 0.f;
#pragma unroll
        for (int s = 0; s < 8; ++s) { const bf16x8 kf = *(const LAS bf16x8*)(kread + 32 * s); st = MFMA32(kf, qf[s], st); }
        const bool diag = (kt == qt);
        float sp[16], la[16], ex[16];
#pragma unroll
        for (int r = 0; r < 16; ++r) { const float z = st[r] * QK_SCALE; const float spv = softplusf_(z); const bool valid = !diag || (crow(r, hh) < n);
            sp[r] = valid ? spv : 0.f; la[r] = valid ? (z - spv) : -1.0e30f; }
        float own[4], par[4];
#pragma unroll
        for (int g = 0; g < 4; ++g) { ex[4 * g + 3] = 0.f; ex[4 * g + 2] = sp[4 * g + 3]; ex[4 * g + 1] = ex[4 * g + 2] + sp[4 * g + 2]; ex[4 * g] = ex[4 * g + 1] + sp[4 * g + 1]; own[g] = ex[4 * g] + sp[4 * g]; }
#pragma unroll
        for (int g = 0; g < 4; ++g) par[g] = __shfl_xor(own[g], 32);
        float U[4];
        U[3] = 0.f; U[2] = own[3] + par[3]; U[1] = U[2] + (own[2] + par[2]); U[0] = U[1] + (own[1] + par[1]);
        const float total = U[0] + (own[0] + par[0]);
        float w[16];
#pragma unroll
        for (int r = 0; r < 16; ++r) { const int g = r >> 2; const float after = R + U[g] + (hh == 0 ? par[g] : 0.f) + ex[r]; w[r] = __expf(la[r] - after); }
        R += total;
        const bf16x8 wf0 = pack8(w[0], w[1], w[2], w[3], w[4], w[5], w[6], w[7]), wf1 = pack8(w[8], w[9], w[10], w[11], w[12], w[13], w[14], w[15]);
#pragma unroll
        for (int cb = 0; cb < 4; ++cb) {
            const bf16x8 v0 = trfrag(vread + 64 * cb, 8 * SB_KS), v1 = trfrag(vread + 16 * SB_KS + 64 * cb, 8 * SB_KS);
            oT[cb] = MFMA32(v0, wf0, oT[cb]); oT[cb] = MFMA32(v1, wf1, oT[cb]); }
        asm volatile("s_waitcnt lgkmcnt(0)" ::: "memory");
        if (__ballot(R <= 104.0f) == 0ull) break;
    }
    const size_t mrow = (rowbase + 32 * qt + n) * HW;
#pragma unroll
    for (int cb = 0; cb < 4; ++cb)
#pragma unroll
        for (int g = 0; g < 4; ++g) { const int dh0 = hd * 128 + 32 * cb + 8 * g + 4 * hh;
            const v2u mb = *(const v2u*)(H + mrow + C_MB + dh0);
            const float g0 = sigmoidf_(__uint_as_float(mb.x << 16)), g1 = sigmoidf_(__uint_as_float(mb.x & 0xffff0000u)), g2 = sigmoidf_(__uint_as_float(mb.y << 16)), g3 = sigmoidf_(__uint_as_float(mb.y & 0xffff0000u));
            v2u o; o.x = cvtpk(oT[cb][4 * g] * g0, oT[cb][4 * g + 1] * g1); o.y = cvtpk(oT[cb][4 * g + 2] * g2, oT[cb][4 * g + 3] * g3);
            *(v2u*)(H + mrow + C_SQ + dh0) = o; }
}
constexpr int GL_QS = 272, GL_VS = 528;
constexpr int GL_QE = 0, GL_KE = 64 * GL_QS, GL_KD = 2 * 64 * GL_QS, GL_VV = 3 * 64 * GL_QS, GL_GA = GL_VV + 64 * GL_VS, GL_SEG = GL_GA + 4096, GL_EB = GL_SEG + 2048, GL_SSQ = GL_EB + 512, GL_END = GL_SSQ + 2048;
static_assert(GL_END <= 131072, "GLA LDS map");
constexpr int GL_NSEG = 8, GL_SEGCH = (SEQ / 64) / GL_NSEG, GL_STATE = 8 * 4 * 16 * 64;
template <bool FULL>
__device__ __forceinline__ void gla_seg(bf16* H, const bf16* GA, const float* w_up, const float* b_alpha, const float* gng, float* Lst, float* Lsum, LAS unsigned char* lds, int unit, int tid) {
    const int b = unit >> 5, hg = (unit >> 3) & 3, sj = unit & 7;
    const int lane = tid & 63, wave = tid >> 6, n = lane & 31, hh = lane >> 5, i16 = lane & 15, tq = i16 >> 2, tp = i16 & 3, blk = (lane >> 4) & 1;
    const int d = tid & 127, seg = tid >> 7;
    float wup[16];
#pragma unroll
    for (int r = 0; r < 16; ++r) wup[r] = w_up[r * 512 + hg * 128 + d];
    const float bal = b_alpha[hg * 128 + d];
    f32x16 sacc[4];
#pragma unroll
    for (int db = 0; db < 4; ++db)
#pragma unroll
        for (int r = 0; r < 16; ++r) sacc[db][r] = 0.f;
    LAS float* GAc = (LAS float*)(lds + GL_GA); LAS float* SEG = (LAS float*)(lds + GL_SEG); LAS float* EB = (LAS float*)(lds + GL_EB); LAS float* SSQ = (LAS float*)(lds + GL_SSQ);
    const LAS unsigned char* vtr_base = lds + GL_VV + (4 * hh + tq) * GL_VS + (32 * wave + 16 * blk + 4 * tp) * 2;
    const LAS unsigned char* kdtr_base = lds + GL_KD + (4 * hh + tq) * GL_QS + (16 * blk + 4 * tp) * 2;
    float lsum = 0.f;
    if (FULL) {
        for (int jp = 0; jp < sj; ++jp) { const int up = unit - sj + jp;
            __syncthreads(); if (tid < 128) EB[tid] = __expf(Lsum[up * 128 + tid]); __syncthreads();
            const float* Lp = Lst + (size_t)up * GL_STATE + (size_t)wave * 4 * 16 * 64 + lane;
#pragma unroll
            for (int db = 0; db < 4; ++db)
#pragma unroll
                for (int g = 0; g < 4; ++g) { const f32x4 e4 = *(const LAS f32x4*)(EB + 32 * db + 8 * g + 4 * hh);
#pragma unroll
                    for (int j = 0; j < 4; ++j) sacc[db][4 * g + j] = sacc[db][4 * g + j] * e4[j] + Lp[(db * 16 + 4 * g + j) * 64]; } }
        __syncthreads();
    }
    for (int c = sj * GL_SEGCH; c < (sj + 1) * GL_SEGCH; ++c) {
        const size_t m0 = (size_t)b * SEQ + 64 * c;
        unsigned short qraw[16], kraw[16];
#pragma unroll
        for (int ii = 0; ii < 16; ++ii) { const bf16* rp = H + (m0 + 16 * seg + ii) * HW + hg * 128 + d; qraw[ii] = FULL ? rp[C_GQ] : (unsigned short)0; kraw[ii] = rp[C_GK]; }
#pragma unroll
        for (int e = tid; e < 1024; e += NTHR) GAc[e] = bf2f(GA[m0 * 16 + e]);
#pragma unroll
        for (int i = 0; i < 4; ++i) { const int id = tid + NTHR * i, row = id >> 5, ch = id & 31;
            *(LAS v4u*)(lds + GL_VV + row * GL_VS + ch * 16) = *(const v4u*)(H + (m0 + row) * HW + C_GV + hg * 256 + ch * 8); }
        __syncthreads();
        float bb[16]; float run = 0.f;
#pragma unroll
        for (int ii = 0; ii < 16; ++ii) { const LAS f32x4* g4 = (const LAS f32x4*)(GAc + (16 * seg + ii) * 16); float z = bal;
#pragma unroll
            for (int r4 = 0; r4 < 4; ++r4) { const f32x4 gv = g4[r4]; z += gv.x * wup[4 * r4] + gv.y * wup[4 * r4 + 1] + gv.z * wup[4 * r4 + 2] + gv.w * wup[4 * r4 + 3]; }
            run += -softplusf_(-z) * (1.0f / 16.0f); bb[ii] = run; }
        SEG[seg * 128 + d] = run;
        __syncthreads();
        { const float t0 = SEG[d], t1 = SEG[128 + d], t2 = SEG[256 + d], t3 = SEG[384 + d];
          const float off = (seg > 0 ? t0 : 0.f) + (seg > 1 ? t1 : 0.f) + (seg > 2 ? t2 : 0.f); const float blast = ((t0 + t1) + t2) + t3;
          if (seg == 0) { EB[d] = __expf(blast); lsum += blast; }
#pragma unroll
          for (int ii = 0; ii < 16; ++ii) { const int i = 16 * seg + ii; const float bi = bb[ii] + off; const float qv = bf2f(qraw[ii]), kv = bf2f(kraw[ii]);
              if (FULL) { *(LAS unsigned short*)(lds + GL_QE + i * GL_QS + d * 2) = (unsigned short)(cvtpk(qv * QK_SCALE * __expf(bi), 0.f) & 0xffffu);
                          *(LAS unsigned short*)(lds + GL_KE + i * GL_QS + d * 2) = (unsigned short)(cvtpk(kv * __expf(-bi), 0.f) & 0xffffu); }
              *(LAS unsigned short*)(lds + GL_KD + i * GL_QS + d * 2) = (unsigned short)(cvtpk(kv * __expf(blast - bi), 0.f) & 0xffffu); } }
        __syncthreads();
        f32x16 oT[2];
#pragma unroll
        for (int tb = 0; tb < 2; ++tb)
#pragma unroll
            for (int r = 0; r < 16; ++r) oT[tb][r] = 0.f;
        if (FULL) {
#pragma unroll
        for (int db = 0; db < 4; ++db)
#pragma unroll
            for (int s = 0; s < 2; ++s) { const bf16x8 sf = PACK_STEP(sacc[db], s);
#pragma unroll
                for (int tb = 0; tb < 2; ++tb) { const LAS unsigned char* qb = lds + GL_QE + (32 * tb + n) * GL_QS + (32 * db + 16 * s + 4 * hh) * 2;
                    const s16x4 lo = *(const LAS s16x4*)qb, hi = *(const LAS s16x4*)(qb + 16); const bf16x8 bq = __builtin_shufflevector(lo, hi, 0, 1, 2, 3, 4, 5, 6, 7);
                    oT[tb] = MFMA32(sf, bq, oT[tb]); } }
        }
        bf16x8 vf[2][2];
#pragma unroll
        for (int sb = 0; sb < 2; ++sb)
#pragma unroll
            for (int s2 = 0; s2 < 2; ++s2) vf[sb][s2] = trfrag(vtr_base + (32 * sb + 16 * s2) * GL_VS, 8 * GL_VS);
        if (FULL) {
#pragma unroll
        for (int blk3 = 0; blk3 < 3; ++blk3) { const int sb = blk3 >> 1, tb = (blk3 + 1) >> 1;
            f32x16 pt;
#pragma unroll
            for (int r = 0; r < 16; ++r) pt[r] = 0.f;
#pragma unroll
            for (int ks = 0; ks < 8; ++ks) { const bf16x8 ka = *(const LAS bf16x8*)(lds + GL_KE + (32 * sb + n) * GL_QS + (16 * ks + 8 * hh) * 2);
                const bf16x8 qb = *(const LAS bf16x8*)(lds + GL_QE + (32 * tb + n) * GL_QS + (16 * ks + 8 * hh) * 2); pt = MFMA32(ka, qb, pt); }
            if (sb == tb) {
#pragma unroll
                for (int r = 0; r < 16; ++r) pt[r] = (crow(r, hh) <= n) ? pt[r] : 0.f; }
            const bf16x8 p0 = PACK_STEP(pt, 0), p1 = PACK_STEP(pt, 1);
            oT[tb] = MFMA32(vf[sb][0], p0, oT[tb]); oT[tb] = MFMA32(vf[sb][1], p1, oT[tb]); }
        }
#pragma unroll
        for (int db = 0; db < 4; ++db) {
#pragma unroll
            for (int g = 0; g < 4; ++g) { const f32x4 e4 = *(const LAS f32x4*)(EB + 32 * db + 8 * g + 4 * hh);
                sacc[db][4 * g] *= e4.x; sacc[db][4 * g + 1] *= e4.y; sacc[db][4 * g + 2] *= e4.z; sacc[db][4 * g + 3] *= e4.w; }
#pragma unroll
            for (int sb = 0; sb < 2; ++sb)
#pragma unroll
                for (int s2 = 0; s2 < 2; ++s2) { const bf16x8 kdf = trfrag(kdtr_base + (32 * sb + 16 * s2) * GL_QS + 64 * db, 8 * GL_QS); sacc[db] = MFMA32(kdf, vf[sb][s2], sacc[db]); } }
        if (!FULL) { __syncthreads(); continue; }
#pragma unroll
        for (int tb = 0; tb < 2; ++tb) { float ss = 0.f;
#pragma unroll
            for (int r = 0; r < 16; ++r) ss += oT[tb][r] * oT[tb][r];
            ss += __shfl_xor(ss, 32); if (hh == 0) SSQ[wave * 64 + 32 * tb + n] = ss; }
        __syncthreads();
#pragma unroll
        for (int tb = 0; tb < 2; ++tb) { const int t = 32 * tb + n; float tot = 0.f;
#pragma unroll
            for (int w8 = 0; w8 < 8; ++w8) tot += SSQ[w8 * 64 + t];
            const float rstd = 1.0f / sqrtf(tot * (1.0f / 256.0f) + LN_EPS); bf16* rowp = H + (m0 + t) * HW;
#pragma unroll
            for (int g = 0; g < 4; ++g) { const int col = hg * 256 + 32 * wave + 8 * g + 4 * hh;
                const v2u gg = *(const v2u*)(rowp + C_GG + col), ma = *(const v2u*)(rowp + C_MA + col), os = *(const v2u*)(rowp + C_SQ + col); const f32x4 gn = *(const f32x4*)(gng + col);
                const float x0 = __uint_as_float(gg.x << 16), x1 = __uint_as_float(gg.x & 0xffff0000u), x2 = __uint_as_float(gg.y << 16), x3 = __uint_as_float(gg.y & 0xffff0000u);
                const float a0 = __uint_as_float(ma.x << 16), a1 = __uint_as_float(ma.x & 0xffff0000u), a2 = __uint_as_float(ma.y << 16), a3 = __uint_as_float(ma.y & 0xffff0000u);
                const float o0 = oT[tb][4 * g] * rstd * gn.x * (x0 * sigmoidf_(x0)) * sigmoidf_(a0), o1 = oT[tb][4 * g + 1] * rstd * gn.y * (x1 * sigmoidf_(x1)) * sigmoidf_(a1);
                const float o2 = oT[tb][4 * g + 2] * rstd * gn.z * (x2 * sigmoidf_(x2)) * sigmoidf_(a2), o3 = oT[tb][4 * g + 3] * rstd * gn.w * (x3 * sigmoidf_(x3)) * sigmoidf_(a3);
                v2u o; o.x = cvtpk(o0 + __uint_as_float(os.x << 16), o1 + __uint_as_float(os.x & 0xffff0000u)); o.y = cvtpk(o2 + __uint_as_float(os.y << 16), o3 + __uint_as_float(os.y & 0xffff0000u)); *(v2u*)(rowp + C_GG + col) = o; } }
    }
    if (!FULL) {
        float* Lp = Lst + (size_t)unit * GL_STATE + (size_t)wave * 4 * 16 * 64 + lane;
#pragma unroll
        for (int db = 0; db < 4; ++db)
#pragma unroll
            for (int r = 0; r < 16; ++r) Lp[(db * 16 + r) * 64] = sacc[db][r];
        if (tid < 128) Lsum[unit * 128 + tid] = lsum;
    }
}
__global__ void __launch_bounds__(NTHR, 2) fwd_megakernel(Args args) {
    extern __shared__ __attribute__((aligned(16))) unsigned char lds_raw[];
    cg::grid_group grid = cg::this_grid();
    LAS unsigned char* lds = (LAS unsigned char*)lds_raw;
    const int tid = threadIdx.x, lane = tid & 63, wave = __builtin_amdgcn_readfirstlane(tid >> 6);
    const int G = gridDim.x, bx = blockIdx.x;
    const float* x = args.in[0]; const float* cvec = args.in[1]; const float* w_ada = args.in[2]; const float* b_ada = args.in[3]; const float* w_in = args.in[4];
    const float* w_up = args.in[5]; const float* b_alpha = args.in[6]; const float* gng = args.in[7]; const float* w_out = args.in[8];
    const float* ln1_g = args.in[9]; const float* ln1_b = args.in[10]; const float* w_ffin = args.in[11]; const float* w_ffout = args.in[12]; const float* ln2_g = args.in[13]; const float* ln2_b = args.in[14];
    unsigned char* dsc = (unsigned char*)args.out;
    bf16* H = (bf16*)args.ws; float* Hf = (float*)args.ws;
    bf16* U1 = (bf16*)(dsc + DO_U1); bf16* Wt_in = (bf16*)(dsc + DO_WIN); bf16* Wt_out = (bf16*)(dsc + DO_WOUT); bf16* Wt_ffin = (bf16*)(dsc + DO_WFFIN); bf16* Wt_ffout = (bf16*)(dsc + DO_WFFOUT);
    bf16* GA = (bf16*)(dsc + DO_GA); float* Lst = (float*)(dsc + DO_U1); float* Lsum = (float*)(dsc + DO_U1 + 32 * MiB); float* modp = (float*)(dsc + DO_MODP); float* modf = (float*)(dsc + DO_MODF);

    {
        LAS float* scr = (LAS float*)(lds + wave * 16384);
        const int gw = bx * NWAVES + wave, NGW = G * NWAVES;
        constexpr int I_ADA = 96 * 16, I_IN = (NIN / 32) * (D / 64), I_OUT = (D / 32) * (D / 64), I_FI = (2 * FF / 32) * (D / 64), I_FO = (D / 32) * (FF / 64);
        constexpr int NITEMS = I_ADA + I_IN + I_OUT + I_FI + I_FO;
        for (int it = gw; it < NITEMS; it += NGW) {
            int r = it;
            if (r < I_ADA) {
                const int cgp = r % 96, ks = r / 96, col = 64 * cgp + lane, k0 = 64 * ks;
                float sc[8], acc[8];
#pragma unroll
                for (int b = 0; b < 8; ++b) { const float cv = cvec[b * D + k0 + lane]; sc[b] = cv * sigmoidf_(cv); acc[b] = 0.f; }
#pragma unroll 8
                for (int kk = 0; kk < 64; ++kk) { const float w = w_ada[(size_t)(k0 + kk) * NMOD + col];
#pragma unroll
                    for (int b = 0; b < 8; ++b) acc[b] += __shfl(sc[b], kk) * w; }
#pragma unroll
                for (int b = 0; b < 8; ++b) modp[(size_t)(ks * 8 + b) * NMOD + col] = acc[b];
                continue;
            }
            r -= I_ADA;
            if (r < I_IN) { transpose_item(w_in, 8208, Wt_in, D, 32 * (r % (NIN / 32)), 64 * (r / (NIN / 32)), 0, false, scr, lane); continue; } r -= I_IN;
            if (r < I_OUT) { transpose_item(w_out, D, Wt_out, D, 32 * (r % (D / 32)), 64 * (r / (D / 32)), 2, false, scr, lane); continue; } r -= I_OUT;
            if (r < I_FI) { transpose_item(w_ffin, 2 * FF, Wt_ffin, D, 32 * (r % (2 * FF / 32)), 64 * (r / (2 * FF / 32)), 1, false, scr, lane); continue; } r -= I_FI;
            transpose_item(w_ffout, D, Wt_ffout, FF, 32 * (r % (D / 32)), 64 * (r / (D / 32)), 2, false, scr, lane);
        }
    }
    grid.sync();

    {
        for (int idx = bx * NTHR + tid; idx < BATCH * NMOD; idx += G * NTHR) { const int b = idx / NMOD, j = idx % NMOD; float s = b_ada[j];
#pragma unroll
            for (int ks = 0; ks < 16; ++ks) s += modp[(size_t)(ks * 8 + b) * NMOD + j];
            modf[idx] = s; }
        LAS float* ssh = (LAS float*)lds; LAS float* ssc = ssh + D;
        for (int rg = bx; rg < M / 128; rg += G) {
            const int b = rg / (SEQ / 128);
            __syncthreads();
            for (int j = tid; j < 2 * D; j += NTHR) { float s = b_ada[j];
#pragma unroll
                for (int ks = 0; ks < 16; ++ks) s += modp[(size_t)(ks * 8 + b) * NMOD + j];
                ssh[j] = s; }
            __syncthreads();
            for (int i = 0; i < 16; ++i) { const size_t row = (size_t)rg * 128 + wave * 16 + i;
                const f32x4* xr = (const f32x4*)(x + row * D) + lane; f32x4 v[4];
#pragma unroll
                for (int j = 0; j < 4; ++j) v[j] = xr[64 * j];
                float rstd; row_stats(v, rstd);
                unsigned long long* o8 = (unsigned long long*)(U1 + row * D) + lane;
#pragma unroll
                for (int j = 0; j < 4; ++j) { const int c0 = 4 * lane + 256 * j; const f32x4 sc = *(const LAS f32x4*)(ssc + c0), sh = *(const LAS f32x4*)(ssh + c0);
                    const f32x4 o = v[j] * rstd * (sc + 1.0f) + sh; o8[64 * j] = (unsigned long long)cvtpk(o.x, o.y) | ((unsigned long long)cvtpk(o.z, o.w) << 32); } }
        }
    }
    grid.sync();

    { pg8::Gemm g{U1, Wt_in, M, NIN, D, D}; pg8::StaticOrder S; S.init(M, NIN, G, bx); pg8::EpiH E{H, GA};
      pg8::gemm_phase<pg8::EpiH, pg8::StaticOrder, PG8_ALIGN, PG8_SP2>(lds, g, S, E); }
    grid.sync();

    {
        for (int unit = bx; unit < BATCH * 4 * GL_NSEG; unit += G) { if ((unit & 7) != 7) { int t_ = tid; asm volatile("" : "+v"(t_)); gla_seg<false>(H, GA, w_up, b_alpha, gng, Lst, Lsum, lds, unit, t_); } __syncthreads(); }
        LAS unsigned char* wl = lds + wave * (64 * SB_KS);
        for (int u = bx * NWAVES + wave; u < BATCH * 8 * (SEQ / 32); u += G * NWAVES) { const int qt = u & 127, bh = u >> 7; int l_ = lane; asm volatile("" : "+v"(l_)); sb_unit(H, wl, bh >> 3, bh & 7, qt, l_); }
    }
    grid.sync();
    for (int unit = bx; unit < BATCH * 4 * GL_NSEG; unit += G) { __syncthreads(); int t_ = tid; asm volatile("" : "+v"(t_)); gla_seg<true>(H, GA, w_up, b_alpha, gng, Lst, Lsum, lds, unit, t_); }
    grid.sync();

    { pg8::Gemm g{H + C_GG, Wt_out, M, D, D, HW}; pg8::StaticOrder S; S.init(M, D, G, bx); pg8::EpiRes E{x, D, Hf + F_R, HROWF, modf + 2 * D, ALPHA};
      pg8::gemm_phase<pg8::EpiRes, pg8::StaticOrder, PG8_ALIGN, PG8_SP2>(lds, g, S, E); }
    grid.sync();

    {
        LAS float* sg = (LAS float*)lds; LAS float* sb_ = sg + D; LAS float* ssh = sb_ + D; LAS float* ssc = ssh + D;
        for (int rg = bx; rg < M / 128; rg += G) {
            const int b = rg / (SEQ / 128);
            __syncthreads();
            for (int j = tid; j < D; j += NTHR) { sg[j] = ln1_g[j]; sb_[j] = ln1_b[j]; ssh[j] = modf[(size_t)b * NMOD + 3 * D + j]; ssc[j] = modf[(size_t)b * NMOD + 4 * D + j]; }
            __syncthreads();
            for (int i = 0; i < 16; ++i) { const size_t row = (size_t)rg * 128 + wave * 16 + i;
                const f32x4* rr = (const f32x4*)(Hf + row * HROWF + F_R) + lane; f32x4 v[4];
#pragma unroll
                for (int j = 0; j < 4; ++j) v[j] = rr[64 * j];
                float rstd; row_stats(v, rstd);
                f32x4* x1o = (f32x4*)(Hf + row * HROWF + F_X1) + lane;
#pragma unroll
                for (int j = 0; j < 4; ++j) { const int c0 = 4 * lane + 256 * j; v[j] = v[j] * rstd * *(const LAS f32x4*)(sg + c0) + *(const LAS f32x4*)(sb_ + c0); x1o[64 * j] = v[j]; }
                row_stats(v, rstd);
                unsigned long long* o8 = (unsigned long long*)(H + row * HW + C_U2) + lane;
#pragma unroll
                for (int j = 0; j < 4; ++j) { const int c0 = 4 * lane + 256 * j; const f32x4 o = v[j] * rstd * (*(const LAS f32x4*)(ssc + c0) + 1.0f) + *(const LAS f32x4*)(ssh + c0);
                    o8[64 * j] = (unsigned long long)cvtpk(o.x, o.y) | ((unsigned long long)cvtpk(o.z, o.w) << 32); } }
        }
    }
    grid.sync();

    { pg8::Gemm g{H + C_U2, Wt_ffin, M, 2 * FF, D, HW}; pg8::StaticOrder S; S.init(M, 2 * FF, G, bx); pg8::EpiSwiglu E{H + C_ACT, HW};
      pg8::gemm_phase<pg8::EpiSwiglu, pg8::StaticOrder, PG8_ALIGN, PG8_SP2>(lds, g, S, E); }
    grid.sync();

    { pg8::Gemm g{H + C_ACT, Wt_ffout, M, D, FF, HW}; pg8::StaticOrder S; S.init(M, D, G, bx); pg8::EpiRes E{Hf + F_X1, HROWF, Hf + F_R, HROWF, modf + 5 * D, ALPHA};
      pg8::gemm_phase<pg8::EpiRes, pg8::StaticOrder, PG8_ALIGN, PG8_SP2>(lds, g, S, E); }
    grid.sync();

    {
        for (size_t row = (size_t)bx * NWAVES + wave; row < (size_t)M; row += (size_t)G * NWAVES) {
            const f32x4* rr = (const f32x4*)(Hf + row * HROWF + F_R) + lane; f32x4 v[4];
#pragma unroll
            for (int j = 0; j < 4; ++j) v[j] = rr[64 * j];
            float rstd; row_stats(v, rstd);
            f32x4* oo = (f32x4*)(args.out + row * D) + lane;
#pragma unroll
            for (int j = 0; j < 4; ++j) { const int c0 = 4 * lane + 256 * j; oo[64 * j] = v[j] * rstd * *(const f32x4*)(ln2_g + c0) + *(const f32x4*)(ln2_b + c0); }
        }
    }
}

extern "C" void kernel_launch(void* const* d_in, const int* in_sizes, int n_in, void* d_out, int out_size, void* d_ws, size_t ws_size, hipStream_t stream) {
    static int grid = 0;
    if (grid == 0) {
        if (n_in != 15 || out_size != M * D || ws_size < (size_t)M * HW * 2) { fprintf(stderr, "kernel_launch: unexpected problem shape (n_in %d, out %d, ws %zu)\n", n_in, out_size, ws_size); grid = -1; return; }
        int dev = 0, cus = 0, per_cu = 0;
        if (hipGetDevice(&dev) != hipSuccess || hipDeviceGetAttribute(&cus, hipDeviceAttributeMultiprocessorCount, dev) != hipSuccess) { grid = -1; return; }
        if (hipFuncSetAttribute((const void*)fwd_megakernel, hipFuncAttributeMaxDynamicSharedMemorySize, LDS_BYTES) != hipSuccess) { fprintf(stderr, "kernel_launch: hipFuncSetAttribute failed\n"); grid = -1; return; }
        if (hipOccupancyMaxActiveBlocksPerMultiprocessor(&per_cu, (const void*)fwd_megakernel, NTHR, LDS_BYTES) != hipSuccess || per_cu < 1) { fprintf(stderr, "kernel_launch: occupancy query gave %d\n", per_cu); per_cu = 1; }
        (void)hipGetLastError();
        grid = cus * per_cu;
    }
    if (grid < 0) return;
    Args a{};
    for (int i = 0; i < 15; ++i) a.in[i] = (const float*)d_in[i];
    a.out = (float*)d_out; a.ws = (unsigned char*)d_ws;
    void* kargs[] = {&a};
    const hipError_t e = hipLaunchCooperativeKernel((const void*)fwd_megakernel, dim3(grid), dim3(NTHR), kargs, LDS_BYTES, stream);
    if (e != hipSuccess) fprintf(stderr, "kernel_launch: cooperative launch failed: %s (grid %d)\n", hipGetErrorString(e), grid);
}
```

```cpp
#include <hip/hip_runtime.h>
#include <hip/hip_cooperative_groups.h>
#include <cstdio>
#include <cstdint>
namespace cg = cooperative_groups;
namespace pg8 {
#define PG8_LAS __attribute__((address_space(3)))
typedef unsigned short bf16_t;
typedef short bf16x8 __attribute__((ext_vector_type(8)));
typedef float f32x4 __attribute__((ext_vector_type(4)));
typedef unsigned u32x4 __attribute__((ext_vector_type(4)));
constexpr int BM = 256, BK = 64, HALF = 128, HTB = HALF * BK * 2  , STAGE_BYTES = 8 * HTB, NXCD = 8, WGM = 8;

__host__ __device__ __forceinline__ int lds_byte(int r, int c) { const int st = (r >> 4) * 2 + (c >> 5), rr = r & 15, cc = c & 31, ob = rr * 64 + cc * 2; return st * 1024 + (ob ^ (((ob >> 9) & 1) << 5)); }
__host__ __device__ __forceinline__ void stage_rc(int b, int& R, int& C) { const int st = b / 1024, sb = b % 1024, swz = sb ^ (((sb >> 9) & 1) << 5); R = (st >> 1) * 16 + swz / 64; C = (st & 1) * 32 + (swz % 64) / 2; }
__host__ __device__ __forceinline__ int perm32(int rho) { const int n = rho >> 4, i = rho & 15; return 8 * (i >> 2) + 4 * n + (i & 3); }

struct Unit { int pm, pn; };
struct Gemm { const bf16_t* A; const bf16_t* Bt; int M, N, K, lda; };

struct StaticOrder {
    int nM, nN, nwg, G, c;
    __host__ __device__ void init(int M, int N, int G_, int c_) { nM = M / BM; nN = N / BM; nwg = nM * nN; G = G_; c = c_; }
    __host__ __device__ bool next(int i, Unit& u) const {
        const long L = (long)i * G + c; if (L >= nwg) return false;
        int wgid = (int)L; { const int q = nwg / NXCD, r = nwg % NXCD, xcd = wgid % NXCD, off = wgid / NXCD; wgid = (xcd < r ? xcd * (q + 1) : r * (q + 1) + (xcd - r) * q) + off; }
        const int nig = WGM * nN, gid = wgid / nig, fm = gid * WGM, gsz = (nM - fm) < WGM ? (nM - fm) : WGM;
        u.pm = fm + ((wgid % nig) % gsz); u.pn = (wgid % nig) / gsz; return true;
    }
    __device__ __forceinline__ void a_ready(const Unit&) const {}
    __device__ __forceinline__ void done(const Unit&) const {}
};

__device__ __forceinline__ unsigned cvt_pk_bf16(float lo, float hi) { unsigned r; asm volatile("v_cvt_pk_bf16_f32 %0, %1, %2" : "=v"(r) : "v"(lo), "v"(hi)); return r; }
typedef __bf16 bf16x2_t __attribute__((ext_vector_type(2)));
typedef float f32x2_t __attribute__((ext_vector_type(2)));
typedef unsigned u32x2 __attribute__((ext_vector_type(2)));
__device__ __forceinline__ unsigned cvtpk(float lo, float hi) { f32x2_t v = {lo, hi}; bf16x2_t b = __builtin_convertvector(v, bf16x2_t); return __builtin_bit_cast(unsigned, b); }

struct EpiH {
    static constexpr bool PERM = true, AFTER_DRAIN = false;
    bf16_t* H; bf16_t* GA;
    __device__ __forceinline__ void operator()(const f32x4 (&acc)[2][2][4][2], const Unit& u, int wr, int wc, int fr, int fq) const {
        const int row0 = u.pm * BM + wr * 64 + fr;
        if (u.pn < 32) {
            const int col0 = u.pn * BM + wc * 32 + 8 * fq;
#pragma unroll
            for (int ai = 0; ai < 2; ++ai)
#pragma unroll
                for (int m = 0; m < 4; ++m) { bf16_t* rowp = H + (size_t)(row0 + ai * HALF + m * 16) * 8192 + col0;
#pragma unroll
                    for (int bj = 0; bj < 2; ++bj) { const f32x4 v0 = acc[ai][bj][m][0], v1 = acc[ai][bj][m][1];
                        u32x4 w; w.x = cvtpk(v0[0], v0[1]); w.y = cvtpk(v0[2], v0[3]); w.z = cvtpk(v1[0], v1[1]); w.w = cvtpk(v1[2], v1[3]);
                        *(u32x4*)(rowp + bj * HALF) = w; } }
        } else if (wc == 0 && fq < 2) {
#pragma unroll
            for (int ai = 0; ai < 2; ++ai)
#pragma unroll
                for (int m = 0; m < 4; ++m) { const f32x4 v0 = acc[ai][0][m][0], v1 = acc[ai][0][m][1];
                    u32x4 w; w.x = cvtpk(v0[0], v0[1]); w.y = cvtpk(v0[2], v0[3]); w.z = cvtpk(v1[0], v1[1]); w.w = cvtpk(v1[2], v1[3]);
                    *(u32x4*)(GA + (size_t)(row0 + ai * HALF + m * 16) * 16 + 8 * fq) = w; }
        }
    }
};
struct EpiRes {
    static constexpr bool PERM = false, AFTER_DRAIN = false;
    const float* X; int ldx; float* O; int ldo; const float* gate; float alpha;
    __device__ __forceinline__ void operator()(const f32x4 (&acc)[2][2][4][2], const Unit& u, int wr, int wc, int fr, int fq) const {
        const int b = u.pm >> 4; const int col0 = u.pn * BM + wc * 32 + 4 * fq;
#pragma unroll
        for (int bj = 0; bj < 2; ++bj)
#pragma unroll
            for (int n = 0; n < 2; ++n) { const int c = col0 + bj * HALF + n * 16; const f32x4 gv = *(const f32x4*)(gate + (size_t)b * 6144 + c) + 1.0f;
#pragma unroll
                for (int ai = 0; ai < 2; ++ai)
#pragma unroll
                    for (int m = 0; m < 4; ++m) { const size_t r = (size_t)(u.pm * BM + ai * HALF + wr * 64 + m * 16 + fr);
                        const f32x4 xv = *(const f32x4*)(X + r * ldx + c); *(f32x4*)(O + r * ldo + c) = xv * alpha + gv * acc[ai][bj][m][n]; } }
    }
};
struct EpiSwiglu {
    static constexpr bool PERM = true, AFTER_DRAIN = false;
    bf16_t* O; int ldo;
    __device__ __forceinline__ void operator()(const f32x4 (&acc)[2][2][4][2], const Unit& u, int wr, int wc, int fr, int fq) const {
        const int row0 = u.pm * BM + wr * 64 + fr; const int col0 = u.pn * HALF + wc * 32 + 8 * fq;
#pragma unroll
        for (int ai = 0; ai < 2; ++ai)
#pragma unroll
            for (int m = 0; m < 4; ++m) { float a[8];
#pragma unroll
                for (int n = 0; n < 2; ++n)
#pragma unroll
                    for (int j = 0; j < 4; ++j) { const float g = acc[ai][0][m][n][j], up = acc[ai][1][m][n][j]; a[4 * n + j] = g * __builtin_amdgcn_rcpf(1.0f + __expf(-g)) * up; }
                u32x4 w; w.x = cvtpk(a[0], a[1]); w.y = cvtpk(a[2], a[3]); w.z = cvtpk(a[4], a[5]); w.w = cvtpk(a[6], a[7]);
                *(u32x4*)(O + (size_t)(row0 + ai * HALF + m * 16) * ldo + col0) = w; }
    }
};

template <class Epi, class Sched, bool ALIGN_EPI = false, bool SP2 = false>
__device__ __forceinline__ void gemm_phase(PG8_LAS unsigned char* lds, const Gemm g, const Sched& S, const Epi& E) {
    int tid_ = threadIdx.x; asm volatile("" : "+v"(tid_));
    const int tid = tid_, wid = __builtin_amdgcn_readfirstlane(tid >> 6), lane = tid & 63, wr = wid >> 2, wc = wid & 3, fr = lane & 15, fq = lane >> 4;
    const int K = g.K, nt = K / BK;
    unsigned voffA[2], voffB[2];
#pragma unroll
    for (int i = 0; i < 2; ++i) { int R, C; stage_rc(tid * 16 + i * 8192, R, C); const int Rb = Epi::PERM ? ((R & ~31) + perm32(R & 31)) : R;
        voffA[i] = (unsigned)(R * g.lda + C) * 2u; voffB[i] = (unsigned)(Rb * K + C) * 2u; }
    const size_t kstep = (size_t)(BK * 2);
    const size_t hstepA = (size_t)HALF * g.lda * 2, hstepB = (size_t)HALF * K * 2;
    const size_t tstepA = 2 * hstepA, tstepB = 2 * hstepB;
    const unsigned ldsw = (unsigned)wid * 1024u;
    const int aoff = lds_byte(wr * 64 + fr, fq * 8), boff = lds_byte(wc * 32 + fr, fq * 8);
#define PG8_SA(b, h) (((b) * 2 + (h)) * HTB)
#define PG8_SB(b, h) ((4 + (b) * 2 + (h)) * HTB)
#define PG8_STAGE(bufoff, gbase, voff) do { _Pragma("unroll") for (int _i = 0; _i < 2; ++_i) \
        __builtin_amdgcn_global_load_lds((const unsigned*)((const char*)(gbase) + (voff)[_i]), (PG8_LAS unsigned*)(lds + (bufoff) + ldsw + _i * 8192), 16, 0, 0); } while (0)
#define PG8_LDA(dst, b, h) do { _Pragma("unroll") for (int m = 0; m < 4; ++m) _Pragma("unroll") for (int k = 0; k < 2; ++k) dst[m][k] = *(const PG8_LAS bf16x8*)(lds + PG8_SA(b, h) + aoff + m * 2048 + k * 1024); } while (0)
#define PG8_LDB(dst, b, h) do { _Pragma("unroll") for (int n = 0; n < 2; ++n) _Pragma("unroll") for (int k = 0; k < 2; ++k) dst[n][k] = *(const PG8_LAS bf16x8*)(lds + PG8_SB(b, h) + boff + n * 2048 + k * 1024); } while (0)
#define PG8_MMA(ai, bj, At, Bt) do { __builtin_amdgcn_s_setprio(1); _Pragma("unroll") for (int m = 0; m < 4; ++m) _Pragma("unroll") for (int n = 0; n < 2; ++n) _Pragma("unroll") for (int k = 0; k < 2; ++k) \
        acc[ai][bj][m][n] = __builtin_amdgcn_mfma_f32_16x16x32_bf16(Bt[n][k], At[m][k], acc[ai][bj][m][n], 0, 0, 0); __builtin_amdgcn_s_setprio(0); } while (0)
#define PG8_WAIT_V(n) asm volatile("s_waitcnt vmcnt(" #n ")" ::: "memory")
#define PG8_WAIT_L(n) asm volatile("s_waitcnt lgkmcnt(" #n ")" ::: "memory")
#define PG8_BAR __builtin_amdgcn_s_barrier()
#define PG8_SCHED __builtin_amdgcn_sched_barrier(0)
    Unit cur, nxt; int ui = 0;
    if (!S.next(0, cur)) return;
    f32x4 acc[2][2][4][2];
#pragma unroll
    for (int a = 0; a < 2; ++a)
#pragma unroll
        for (int b = 0; b < 2; ++b)
#pragma unroll
            for (int m = 0; m < 4; ++m)
#pragma unroll
                for (int n = 0; n < 2; ++n) acc[a][b][m][n] = (f32x4){0.f, 0.f, 0.f, 0.f};
    bf16x8 At[4][2], B0[2][2], B1[2][2];
    const char* cA = (const char*)g.A + (size_t)cur.pm * tstepA; const char* cB = (const char*)g.Bt + (size_t)cur.pn * tstepB;
    S.a_ready(cur);
    if constexpr (SP2) {
        PG8_STAGE(PG8_SB(0, 0), cB, voffB); PG8_STAGE(PG8_SB(0, 1), cB + hstepB, voffB); PG8_STAGE(PG8_SA(0, 0), cA, voffA); PG8_STAGE(PG8_SA(0, 1), cA + hstepA, voffA);
        if (wr == 1) PG8_BAR;
        PG8_WAIT_V(2); PG8_BAR;
        PG8_STAGE(PG8_SB(1, 0), cB + kstep, voffB); PG8_STAGE(PG8_SA(1, 0), cA + kstep, voffA); PG8_STAGE(PG8_SB(1, 1), cB + hstepB + kstep, voffB);
        PG8_WAIT_V(6); PG8_BAR;
    } else {
        PG8_STAGE(PG8_SB(0, 0), cB, voffB); PG8_STAGE(PG8_SA(0, 0), cA, voffA); PG8_STAGE(PG8_SB(0, 1), cB + hstepB, voffB); PG8_STAGE(PG8_SA(0, 1), cA + hstepA, voffA);
        if (wr == 1) PG8_BAR;
        PG8_WAIT_V(4); PG8_BAR;
        PG8_STAGE(PG8_SB(1, 0), cB + kstep, voffB); PG8_STAGE(PG8_SA(1, 0), cA + kstep, voffA); PG8_STAGE(PG8_SB(1, 1), cB + hstepB + kstep, voffB);
        PG8_WAIT_V(6); PG8_BAR;
    }
    for (;;) {
        const bool has_next = S.next(ui + 1, nxt);
        const char* nA = has_next ? (const char*)g.A + (size_t)nxt.pm * tstepA : cA; const char* nB = has_next ? (const char*)g.Bt + (size_t)nxt.pn * tstepB : cB;
        for (int t = 0; t < nt; t += 2) {
            const bool last = (t == nt - 2);
            const char* a1 = cA + (size_t)(t + 1) * kstep;
            const char* a2 = last ? nA : cA + (size_t)(t + 2) * kstep; const char* b2 = last ? nB : cB + (size_t)(t + 2) * kstep;
            const char* a3 = a2 + kstep; const char* b3 = b2 + kstep;
            if (last && has_next) S.a_ready(nxt);
            if constexpr (SP2) {
            PG8_LDB(B0, 0, 0); PG8_LDB(B1, 0, 1); PG8_SCHED; PG8_LDA(At, 0, 0); PG8_STAGE(PG8_SA(1, 1), a1 + hstepA, voffA);
            PG8_WAIT_V(8); PG8_WAIT_L(0); PG8_BAR; PG8_MMA(0, 0, At, B0); PG8_MMA(0, 1, At, B1); PG8_BAR; PG8_SCHED;
            PG8_LDA(At, 0, 1); PG8_STAGE(PG8_SB(0, 0), b2, voffB); PG8_STAGE(PG8_SB(0, 1), b2 + hstepB, voffB); PG8_STAGE(PG8_SA(0, 0), a2, voffA);
            PG8_WAIT_V(8); PG8_WAIT_L(0); PG8_BAR; PG8_MMA(1, 0, At, B0); PG8_MMA(1, 1, At, B1); PG8_BAR; PG8_SCHED;
            PG8_LDB(B0, 1, 0); PG8_LDB(B1, 1, 1); PG8_SCHED; PG8_LDA(At, 1, 0); PG8_STAGE(PG8_SA(0, 1), a2 + hstepA, voffA);
            PG8_WAIT_V(8); PG8_WAIT_L(0); PG8_BAR; PG8_MMA(0, 0, At, B0); PG8_MMA(0, 1, At, B1); PG8_BAR; PG8_SCHED;
            PG8_LDA(At, 1, 1); PG8_STAGE(PG8_SB(1, 0), b3, voffB); PG8_STAGE(PG8_SB(1, 1), b3 + hstepB, voffB); PG8_STAGE(PG8_SA(1, 0), a3, voffA);
            PG8_WAIT_V(8); PG8_WAIT_L(0); PG8_BAR; PG8_MMA(1, 0, At, B0); PG8_MMA(1, 1, At, B1); PG8_BAR; PG8_SCHED;
            } else {
            PG8_LDB(B0, 0, 0); PG8_SCHED; PG8_LDA(At, 0, 0); PG8_STAGE(PG8_SA(1, 1), a1 + hstepA, voffA);
            PG8_WAIT_L(8); PG8_BAR; PG8_WAIT_L(0); PG8_MMA(0, 0, At, B0); PG8_BAR; PG8_SCHED;
            PG8_LDB(B1, 0, 1); PG8_STAGE(PG8_SB(0, 0), b2, voffB);
            PG8_BAR; PG8_WAIT_L(0); PG8_MMA(0, 1, At, B1); PG8_BAR;
            PG8_LDA(At, 0, 1); PG8_STAGE(PG8_SA(0, 0), a2, voffA);
            PG8_BAR; PG8_WAIT_L(0); PG8_MMA(1, 0, At, B0); PG8_BAR; PG8_SCHED;
            PG8_STAGE(PG8_SB(0, 1), b2 + hstepB, voffB);
            PG8_WAIT_V(6); PG8_BAR; PG8_MMA(1, 1, At, B1); PG8_BAR;
            PG8_LDB(B0, 1, 0); PG8_SCHED; PG8_LDA(At, 1, 0); PG8_STAGE(PG8_SA(0, 1), a2 + hstepA, voffA);
            PG8_WAIT_L(8); PG8_BAR; PG8_WAIT_L(0); PG8_MMA(0, 0, At, B0); PG8_BAR; PG8_SCHED;
            PG8_LDB(B1, 1, 1); PG8_STAGE(PG8_SB(1, 0), b3, voffB);
            PG8_BAR; PG8_WAIT_L(0); PG8_MMA(0, 1, At, B1); PG8_BAR;
            PG8_LDA(At, 1, 1); PG8_STAGE(PG8_SA(1, 0), a3, voffA);
            PG8_BAR; PG8_WAIT_L(0); PG8_MMA(1, 0, At, B0); PG8_BAR; PG8_SCHED;
            PG8_STAGE(PG8_SB(1, 1), b3 + hstepB, voffB);
            PG8_WAIT_V(6); PG8_BAR; PG8_MMA(1, 1, At, B1); PG8_BAR;
            }
        }
        if constexpr (ALIGN_EPI) { if (wr == 0) PG8_BAR; }
        if constexpr (!Epi::AFTER_DRAIN) { E(acc, cur, wr, wc, fr, fq); S.done(cur); }
        if (!has_next) break;
#pragma unroll
        for (int a = 0; a < 2; ++a)
#pragma unroll
            for (int b = 0; b < 2; ++b)
#pragma unroll
                for (int m = 0; m < 4; ++m)
#pragma unroll
                    for (int n = 0; n < 2; ++n) acc[a][b][m][n] = (f32x4){0.f, 0.f, 0.f, 0.f};
        cur = nxt; cA = nA; cB = nB; ++ui;
        if constexpr (ALIGN_EPI) { if (wr == 1) PG8_BAR; }
    }
    PG8_WAIT_V(0);
    if constexpr (!ALIGN_EPI) { if (wr == 0) PG8_BAR; }
    PG8_BAR;
    if constexpr (Epi::AFTER_DRAIN) { E.fused(acc, cur, wr, wc, fr, fq, lds, wid, lane); S.done(cur); }
#undef PG8_SA
#undef PG8_SB
#undef PG8_STAGE
#undef PG8_LDA
#undef PG8_LDB
#undef PG8_MMA
#undef PG8_WAIT_V
#undef PG8_WAIT_L
#undef PG8_BAR
#undef PG8_SCHED
}
}
#ifndef PG8_SP2
#define PG8_SP2 true
#endif
#ifndef PG8_ALIGN
#define PG8_ALIGN true
#endif
#define LAS __attribute__((address_space(3)))
typedef unsigned short bf16;
typedef short bf16x8 __attribute__((ext_vector_type(8)));
typedef short s16x4 __attribute__((ext_vector_type(4)));
typedef float f32x4 __attribute__((ext_vector_type(4)));
typedef float f32x16 __attribute__((ext_vector_type(16)));
typedef unsigned v4u __attribute__((ext_vector_type(4)));
typedef unsigned v2u __attribute__((ext_vector_type(2)));
using pg8::cvtpk;
constexpr int NWAVES = 8, NTHR = 512;
constexpr int BATCH = 8, SEQ = 4096, D = 1024, M = BATCH * SEQ, FF = 2816, NMOD = 6 * D;
constexpr int HW = 8192;
constexpr int C_GQ = 0, C_GK = 512, C_GV = 1024, C_GG = 2048, C_SQ = 3072, C_SK = 4096, C_SV = 5120, C_MA = 6144, C_MB = 7168;
constexpr int NIN = 8448;
constexpr int C_U2 = 0, C_ACT = 1024;
constexpr int HROWF = 4096, F_R = 2048, F_X1 = 3072;
constexpr float LN_EPS = 1e-5f, ALPHA = 1.189207115002721f;
constexpr float QK_SCALE = 0.08838834764831845f;
constexpr size_t MiB = 1u << 20;
constexpr size_t DO_U1 = 0, DO_WIN = 64 * MiB, DO_WOUT = 81 * MiB, DO_WFFIN = 85 * MiB, DO_WFFOUT = 96 * MiB, DO_GA = 102 * MiB, DO_MODP = 103 * MiB, DO_MODF = 106 * MiB;
static_assert(DO_WIN + (size_t)NIN * D * 2 <= DO_WOUT && DO_WOUT + (size_t)D * 2048 * 2 <= DO_WFFIN && DO_WFFIN + (size_t)2 * FF * D * 2 <= DO_WFFOUT && DO_WFFOUT + (size_t)D * FF * 2 <= DO_GA &&
              DO_GA + (size_t)M * 16 * 2 <= DO_MODP && DO_MODP + (size_t)16 * BATCH * NMOD * 4 <= DO_MODF && DO_MODF + (size_t)BATCH * NMOD * 4 <= 128 * MiB, "d_out scratch map");
constexpr int LDS_BYTES = 147456;

__device__ __forceinline__ float bf2f(unsigned short u) { return __uint_as_float((unsigned)u << 16); }
__device__ __forceinline__ float wave_sum(float v) {
#pragma unroll
    for (int o = 1; o < 64; o <<= 1) v += __shfl_xor(v, o);
    return v;
}
__device__ __forceinline__ int crow(int reg, int h) { return (reg & 3) + 8 * (reg >> 2) + 4 * h; }
#define MFMA32(a, b, c) __builtin_amdgcn_mfma_f32_32x32x16_bf16((a), (b), (c), 0, 0, 0)
__device__ __forceinline__ bf16x8 pack8(float a0, float a1, float a2, float a3, float a4, float a5, float a6, float a7) {
    v4u p; p.x = cvtpk(a0, a1); p.y = cvtpk(a2, a3); p.z = cvtpk(a4, a5); p.w = cvtpk(a6, a7); return __builtin_bit_cast(bf16x8, p);
}
#define PACK_STEP(x, s) pack8((x)[8 * (s)], (x)[8 * (s) + 1], (x)[8 * (s) + 2], (x)[8 * (s) + 3], (x)[8 * (s) + 4], (x)[8 * (s) + 5], (x)[8 * (s) + 6], (x)[8 * (s) + 7])
typedef short v4i16_t __attribute__((ext_vector_type(4)));
__device__ __forceinline__ s16x4 trd(const LAS unsigned char* p) { return __builtin_bit_cast(s16x4, __builtin_amdgcn_ds_read_tr16_b64_v4i16((LAS v4i16_t*)p)); }
__device__ __forceinline__ bf16x8 trfrag(const LAS unsigned char* p, int stride8) { const s16x4 lo = trd(p), hi = trd(p + stride8); return __builtin_shufflevector(lo, hi, 0, 1, 2, 3, 4, 5, 6, 7); }
__device__ __forceinline__ float sigmoidf_(float x) { return __builtin_amdgcn_rcpf(1.0f + __expf(-x)); }
__device__ __forceinline__ float softplusf_(float z) { return fmaxf(z, 0.f) + __logf(1.0f + __expf(-fabsf(z))); }

__device__ __forceinline__ void transpose_item(const float* W, int Nsrc, bf16* WT, int ldw, int d0, int k0, int map, bool dup, LAS float* scr, int lane) {
    const int d = d0 + (lane & 31); int sc;
    if (map == 0) sc = d < 3072 ? d : (d < 8192 ? d + 16 : (d < 8208 ? 3072 + (d - 8192) : -1));
    else if (map == 1) { const int pn = d >> 8, j = d & 255; sc = j < 128 ? 128 * pn + j : FF + 128 * pn + (j - 128); }
    else sc = d;
#pragma unroll 8
    for (int i = 0; i < 32; ++i) { const int kk = 2 * i + (lane >> 5); scr[kk * 33 + (lane & 31)] = sc >= 0 ? W[(size_t)(k0 + kk) * Nsrc + sc] : 0.f; }
    asm volatile("s_waitcnt lgkmcnt(0)" ::: "memory");
    const int c = lane & 7;
#pragma unroll
    for (int j = 0; j < 4; ++j) { const int n = (lane >> 3) + 8 * j; const LAS float* s = scr + (8 * c) * 33 + n;
        v4u o; o.x = cvtpk(s[0 * 33], s[1 * 33]); o.y = cvtpk(s[2 * 33], s[3 * 33]); o.z = cvtpk(s[4 * 33], s[5 * 33]); o.w = cvtpk(s[6 * 33], s[7 * 33]);
        bf16* dst = WT + (size_t)(d0 + n) * ldw + k0 + 8 * c; *(v4u*)dst = o; if (dup) *(v4u*)(dst + 1024) = o; }
    asm volatile("s_waitcnt lgkmcnt(0)" ::: "memory");
}

struct Args { const float* in[15]; float* out; unsigned char* ws; };

__device__ __forceinline__ void row_stats(f32x4 (&v)[4], float& rstd) {
    float s = 0.f;
#pragma unroll
    for (int j = 0; j < 4; ++j) s += (v[j].x + v[j].y) + (v[j].z + v[j].w);
    const float mean = wave_sum(s) * (1.f / D); float s2 = 0.f;
#pragma unroll
    for (int j = 0; j < 4; ++j) { v[j] = v[j] - mean; s2 += (v[j].x * v[j].x + v[j].y * v[j].y) + (v[j].z * v[j].z + v[j].w * v[j].w); }
    rstd = 1.0f / sqrtf(wave_sum(s2) * (1.f / D) + LN_EPS);
}

constexpr int SB_KS = 272;
__device__ __forceinline__ void sb_unit(bf16* H, LAS unsigned char* wl, int b, int hd, int qt, int lane) {
    const int n = lane & 31, hh = lane >> 5, i16 = lane & 15, tq = i16 >> 2, tp = i16 & 3, blk = (lane >> 4) & 1;
    const size_t rowbase = (size_t)b * SEQ;
    bf16x8 qf[8];
    { const bf16* qp = H + (rowbase + 32 * qt + n) * HW + C_SQ + hd * 128 + 8 * hh;
#pragma unroll
      for (int s = 0; s < 8; ++s) qf[s] = *(const bf16x8*)(qp + 16 * s); }
    f32x16 oT[4];
#pragma unroll
    for (int cb = 0; cb < 4; ++cb)
#pragma unroll
        for (int r = 0; r < 16; ++r) oT[cb][r] = 0.f;
    float R = 0.f;
    LAS unsigned char* Kl = wl; LAS unsigned char* Vl = wl + 32 * SB_KS;
    const LAS unsigned char* kread = Kl + n * SB_KS + 16 * hh;
    const LAS unsigned char* vread = Vl + (4 * hh + tq) * SB_KS + (16 * blk + 4 * tp) * 2;
    for (int kt = qt; kt >= 0; --kt) {
        const bf16* kp = H + (rowbase + 32 * kt) * HW + C_SK + hd * 128;
        const bf16* vp = H + (rowbase + 32 * kt) * HW + C_SV + hd * 128;
#pragma unroll
        for (int i = 0; i < 8; ++i) { const int id = lane + 64 * i, row = id >> 4, ch = id & 15;
            const v4u kv = *(const v4u*)(kp + (size_t)row * HW + ch * 8); const v4u vv = *(const v4u*)(vp + (size_t)row * HW + ch * 8);
            *(LAS v4u*)(Kl + row * SB_KS + ch * 16) = kv; *(LAS v4u*)(Vl + row * SB_KS + ch * 16) = vv; }
        asm volatile("s_waitcnt lgkmcnt(0)" ::: "memory");
        f32x16 st;
#pragma unroll
        for (int r = 0; r < 16; ++r) st[r] = 0.f;
#pragma unroll
        for (int s = 0; s < 8; ++s) { const bf16x8 kf = *(const LAS bf16x8*)(kread + 32 * s); st = MFMA32(kf, qf[s], st); }
        const bool diag = (kt == qt);
        float sp[16], la[16], ex[16];
#pragma unroll
        for (int r = 0; r < 16; ++r) { const float z = st[r] * QK_SCALE; const float spv = softplusf_(z); const bool valid = !diag || (crow(r, hh) < n);
            sp[r] = valid ? spv : 0.f; la[r] = valid ? (z - spv) : -1.0e30f; }
        float own[4], par[4];
#pragma unroll
        for (int g = 0; g < 4; ++g) { ex[4 * g + 3] = 0.f; ex[4 * g + 2] = sp[4 * g + 3]; ex[4 * g + 1] = ex[4 * g + 2] + sp[4 * g + 2]; ex[4 * g] = ex[4 * g + 1] + sp[4 * g + 1]; own[g] = ex[4 * g] + sp[4 * g]; }
#pragma unroll
        for (int g = 0; g < 4; ++g) par[g] = __shfl_xor(own[g], 32);
        float U[4];
        U[3] = 0.f; U[2] = own[3] + par[3]; U[1] = U[2] + (own[2] + par[2]); U[0] = U[1] + (own[1] + par[1]);
        const float total = U[0] + (own[0] + par[0]);
        float w[16];
#pragma unroll
        for (int r = 0; r < 16; ++r) { const int g = r >> 2; const float after = R + U[g] + (hh == 0 ? par[g] : 0.f) + ex[r]; w[r] = __expf(la[r] - after); }
        R += total;
        const bf16x8 wf0 = pack8(w[0], w[1], w[2], w[3], w[4], w[5], w[6], w[7]), wf1 = pack8(w[8], w[9], w[10], w[11], w[12], w[13], w[14], w[15]);
#pragma unroll
        for (int cb = 0; cb < 4; ++cb) {
            const bf16x8 v0 = trfrag(vread + 64 * cb, 8 * SB_KS), v1 = trfrag(vread + 16 * SB_KS + 64 * cb, 8 * SB_KS);
            oT[cb] = MFMA32(v0, wf0, oT[cb]); oT[cb] = MFMA32(v1, wf1, oT[cb]); }
        asm volatile("s_waitcnt lgkmcnt(0)" ::: "memory");
        if (__ballot(R <= 104.0f) == 0ull) break;
    }
    const size_t mrow = (rowbase + 32 * qt + n) * HW;
#pragma unroll
    for (int cb = 0; cb < 4; ++cb)
#pragma unroll
        for (int g = 0; g < 4; ++g) { const int dh0 = hd * 128 + 32 * cb + 8 * g + 4 * hh;
            const v2u mb = *(const v2u*)(H + mrow + C_MB + dh0);
            const float g0 = sigmoidf_(__uint_as_float(mb.x << 16)), g1 = sigmoidf_(__uint_as_float(mb.x & 0xffff0000u)), g2 = sigmoidf_(__uint_as_float(mb.y << 16)), g3 = sigmoidf_(__uint_as_float(mb.y & 0xffff0000u));
            v2u o; o.x = cvtpk(oT[cb][4 * g] * g0, oT[cb][4 * g + 1] * g1); o.y = cvtpk(oT[cb][4 * g + 2] * g2, oT[cb][4 * g + 3] * g3);
            *(v2u*)(H + mrow + C_SQ + dh0) = o; }
}
constexpr int GL_QS = 272, GL_VS = 528;
constexpr int GL_QE = 0, GL_KE = 64 * GL_QS, GL_KD = 2 * 64 * GL_QS, GL_VV = 3 * 64 * GL_QS, GL_GA = GL_VV + 64 * GL_VS, GL_SEG = GL_GA + 4096, GL_EB = GL_SEG + 2048, GL_SSQ = GL_EB + 512, GL_WUP = GL_SSQ + 2048, GL_END = GL_WUP + 8192;
static_assert(GL_END <= 131072, "GLA LDS map");
constexpr int GL_NSEG = 8, GL_SEGCH = (SEQ / 64) / GL_NSEG, GL_STATE = 8 * 4 * 16 * 64;
template <bool FULL>
__device__ __forceinline__ void gla_seg(bf16* H, const bf16* GA, const float* w_up, const float* b_alpha, const float* gng, float* Lst, float* Lsum, LAS unsigned char* lds, int unit, int tid) {
    const int b = unit >> 5, hg = (unit >> 3) & 3, sj = unit & 7;
    const int lane = tid & 63, wave = tid >> 6, n = lane & 31, hh = lane >> 5, i16 = lane & 15, tq = i16 >> 2, tp = i16 & 3, blk = (lane >> 4) & 1;
    const int d = tid & 127, seg = tid >> 7;
    LAS float* WUP = (LAS float*)(lds + GL_WUP);
#pragma unroll
    for (int r = 0; r < 4; ++r) WUP[(4 * seg + r) * 128 + d] = w_up[(4 * seg + r) * 512 + hg * 128 + d];
    f32x16 sacc[4];
#pragma unroll
    for (int db = 0; db < 4; ++db)
#pragma unroll
        for (int r = 0; r < 16; ++r) sacc[db][r] = 0.f;
    LAS float* GAc = (LAS float*)(lds + GL_GA); LAS float* SEG = (LAS float*)(lds + GL_SEG); LAS float* EB = (LAS float*)(lds + GL_EB); LAS float* SSQ = (LAS float*)(lds + GL_SSQ);
    const LAS unsigned char* vtr_base = lds + GL_VV + (4 * hh + tq) * GL_VS + (32 * wave + 16 * blk + 4 * tp) * 2;
    const LAS unsigned char* kdtr_base = lds + GL_KD + (4 * hh + tq) * GL_QS + (16 * blk + 4 * tp) * 2;
    float lsum = 0.f;
    if (FULL) {
        for (int jp = 0; jp < sj; ++jp) { const int up = unit - sj + jp;
            __syncthreads(); if (tid < 128) EB[tid] = __expf(Lsum[up * 128 + tid]); __syncthreads();
            const float* Lp = Lst + (size_t)up * GL_STATE + (size_t)wave * 4 * 16 * 64 + lane;
#pragma unroll
            for (int db = 0; db < 4; ++db)
#pragma unroll
                for (int g = 0; g < 4; ++g) { const f32x4 e4 = *(const LAS f32x4*)(EB + 32 * db + 8 * g + 4 * hh);
#pragma unroll
                    for (int j = 0; j < 4; ++j) sacc[db][4 * g + j] = sacc[db][4 * g + j] * e4[j] + Lp[(db * 16 + 4 * g + j) * 64]; } }
        __syncthreads();
    }
    for (int c = sj * GL_SEGCH; c < (sj + 1) * GL_SEGCH; ++c) {
        const size_t m0 = (size_t)b * SEQ + 64 * c;
        unsigned short qraw[16], kraw[16];
#pragma unroll
        for (int ii = 0; ii < 16; ++ii) { const bf16* rp = H + (m0 + 16 * seg + ii) * HW + hg * 128 + d; qraw[ii] = FULL ? rp[C_GQ] : (unsigned short)0; kraw[ii] = rp[C_GK]; }
#pragma unroll
        for (int e = tid; e < 1024; e += NTHR) GAc[e] = bf2f(GA[m0 * 16 + e]);
#pragma unroll
        for (int i = 0; i < 4; ++i) { const int id = tid + NTHR * i, row = id >> 5, ch = id & 31;
            *(LAS v4u*)(lds + GL_VV + row * GL_VS + ch * 16) = *(const v4u*)(H + (m0 + row) * HW + C_GV + hg * 256 + ch * 8); }
        __syncthreads();
        float bb[16]; float run = 0.f; float wup[16]; const float bal = b_alpha[hg * 128 + d];
#pragma unroll
        for (int r = 0; r < 16; ++r) wup[r] = WUP[r * 128 + d];
#pragma unroll
        for (int ii = 0; ii < 16; ++ii) { const LAS f32x4* g4 = (const LAS f32x4*)(GAc + (16 * seg + ii) * 16); float z = bal;
#pragma unroll
            for (int r4 = 0; r4 < 4; ++r4) { const f32x4 gv = g4[r4]; z += gv.x * wup[4 * r4] + gv.y * wup[4 * r4 + 1] + gv.z * wup[4 * r4 + 2] + gv.w * wup[4 * r4 + 3]; }
            run += -softplusf_(-z) * (1.0f / 16.0f); bb[ii] = run; }
        SEG[seg * 128 + d] = run;
        __syncthreads();
        { const float t0 = SEG[d], t1 = SEG[128 + d], t2 = SEG[256 + d], t3 = SEG[384 + d];
          const float off = (seg > 0 ? t0 : 0.f) + (seg > 1 ? t1 : 0.f) + (seg > 2 ? t2 : 0.f); const float blast = ((t0 + t1) + t2) + t3;
          if (seg == 0) { EB[d] = __expf(blast); lsum += blast; }
#pragma unroll
          for (int ii = 0; ii < 16; ++ii) { const int i = 16 * seg + ii; const float bi = bb[ii] + off; const float qv = bf2f(qraw[ii]), kv = bf2f(kraw[ii]);
              if (FULL) { *(LAS unsigned short*)(lds + GL_QE + i * GL_QS + d * 2) = (unsigned short)(cvtpk(qv * QK_SCALE * __expf(bi), 0.f) & 0xffffu);
                          *(LAS unsigned short*)(lds + GL_KE + i * GL_QS + d * 2) = (unsigned short)(cvtpk(kv * __expf(-bi), 0.f) & 0xffffu); }
              *(LAS unsigned short*)(lds + GL_KD + i * GL_QS + d * 2) = (unsigned short)(cvtpk(kv * __expf(blast - bi), 0.f) & 0xffffu); } }
        __syncthreads();
        f32x16 oT[2];
#pragma unroll
        for (int tb = 0; tb < 2; ++tb)
#pragma unroll
            for (int r = 0; r < 16; ++r) oT[tb][r] = 0.f;
        if (FULL) {
#pragma unroll
        for (int db = 0; db < 4; ++db)
#pragma unroll
            for (int s = 0; s < 2; ++s) { const bf16x8 sf = PACK_STEP(sacc[db], s);
#pragma unroll
                for (int tb = 0; tb < 2; ++tb) { const LAS unsigned char* qb = lds + GL_QE + (32 * tb + n) * GL_QS + (32 * db + 16 * s + 4 * hh) * 2;
                    const s16x4 lo = *(const LAS s16x4*)qb, hi = *(const LAS s16x4*)(qb + 16); const bf16x8 bq = __builtin_shufflevector(lo, hi, 0, 1, 2, 3, 4, 5, 6, 7);
                    oT[tb] = MFMA32(sf, bq, oT[tb]); } }
        }
        bf16x8 vf[2][2];
#pragma unroll
        for (int sb = 0; sb < 2; ++sb)
#pragma unroll
            for (int s2 = 0; s2 < 2; ++s2) vf[sb][s2] = trfrag(vtr_base + (32 * sb + 16 * s2) * GL_VS, 8 * GL_VS);
        if (FULL) {
#pragma unroll
        for (int blk3 = 0; blk3 < 3; ++blk3) { const int sb = blk3 >> 1, tb = (blk3 + 1) >> 1;
            f32x16 pt;
#pragma unroll
            for (int r = 0; r < 16; ++r) pt[r] = 0.f;
#pragma unroll
            for (int ks = 0; ks < 8; ++ks) { const bf16x8 ka = *(const LAS bf16x8*)(lds + GL_KE + (32 * sb + n) * GL_QS + (16 * ks + 8 * hh) * 2);
                const bf16x8 qb = *(const LAS bf16x8*)(lds + GL_QE + (32 * tb + n) * GL_QS + (16 * ks + 8 * hh) * 2); pt = MFMA32(ka, qb, pt); }
            if (sb == tb) {
#pragma unroll
                for (int r = 0; r < 16; ++r) pt[r] = (crow(r, hh) <= n) ? pt[r] : 0.f; }
            const bf16x8 p0 = PACK_STEP(pt, 0), p1 = PACK_STEP(pt, 1);
            oT[tb] = MFMA32(vf[sb][0], p0, oT[tb]); oT[tb] = MFMA32(vf[sb][1], p1, oT[tb]); }
        }
#pragma unroll
        for (int db = 0; db < 4; ++db) {
#pragma unroll
            for (int g = 0; g < 4; ++g) { const f32x4 e4 = *(const LAS f32x4*)(EB + 32 * db + 8 * g + 4 * hh);
                sacc[db][4 * g] *= e4.x; sacc[db][4 * g + 1] *= e4.y; sacc[db][4 * g + 2] *= e4.z; sacc[db][4 * g + 3] *= e4.w; }
#pragma unroll
            for (int sb = 0; sb < 2; ++sb)
#pragma unroll
                for (int s2 = 0; s2 < 2; ++s2) { const bf16x8 kdf = trfrag(kdtr_base + (32 * sb + 16 * s2) * GL_QS + 64 * db, 8 * GL_QS); sacc[db] = MFMA32(kdf, vf[sb][s2], sacc[db]); } }
        if (!FULL) { __syncthreads(); continue; }
#pragma unroll
        for (int tb = 0; tb < 2; ++tb) { float ss = 0.f;
#pragma unroll
            for (int r = 0; r < 16; ++r) ss += oT[tb][r] * oT[tb][r];
            ss += __shfl_xor(ss, 32); if (hh == 0) SSQ[wave * 64 + 32 * tb + n] = ss; }
        __syncthreads();
#pragma unroll
        for (int tb = 0; tb < 2; ++tb) { const int t = 32 * tb + n; float tot = 0.f;
#pragma unroll
            for (int w8 = 0; w8 < 8; ++w8) tot += SSQ[w8 * 64 + t];
            const float rstd = 1.0f / sqrtf(tot * (1.0f / 256.0f) + LN_EPS); bf16* rowp = H + (m0 + t) * HW;
#pragma unroll
            for (int g = 0; g < 4; ++g) { const int col = hg * 256 + 32 * wave + 8 * g + 4 * hh;
                const v2u gg = *(const v2u*)(rowp + C_GG + col), ma = *(const v2u*)(rowp + C_MA + col), os = *(const v2u*)(rowp + C_SQ + col); const f32x4 gn = *(const f32x4*)(gng + col);
                const float x0 = __uint_as_float(gg.x << 16), x1 = __uint_as_float(gg.x & 0xffff0000u), x2 = __uint_as_float(gg.y << 16), x3 = __uint_as_float(gg.y & 0xffff0000u);
                const float a0 = __uint_as_float(ma.x << 16), a1 = __uint_as_float(ma.x & 0xffff0000u), a2 = __uint_as_float(ma.y << 16), a3 = __uint_as_float(ma.y & 0xffff0000u);
                const float o0 = oT[tb][4 * g] * rstd * gn.x * (x0 * sigmoidf_(x0)) * sigmoidf_(a0), o1 = oT[tb][4 * g + 1] * rstd * gn.y * (x1 * sigmoidf_(x1)) * sigmoidf_(a1);
                const float o2 = oT[tb][4 * g + 2] * rstd * gn.z * (x2 * sigmoidf_(x2)) * sigmoidf_(a2), o3 = oT[tb][4 * g + 3] * rstd * gn.w * (x3 * sigmoidf_(x3)) * sigmoidf_(a3);
                v2u o; o.x = cvtpk(o0 + __uint_as_float(os.x << 16), o1 + __uint_as_float(os.x & 0xffff0000u)); o.y = cvtpk(o2 + __uint_as_float(os.y << 16), o3 + __uint_as_float(os.y & 0xffff0000u)); *(v2u*)(rowp + C_GG + col) = o; } }
    }
    if (!FULL) {
        float* Lp = Lst + (size_t)unit * GL_STATE + (size_t)wave * 4 * 16 * 64 + lane;
#pragma unroll
        for (int db = 0; db < 4; ++db)
#pragma unroll
            for (int r = 0; r < 16; ++r) Lp[(db * 16 + r) * 64] = sacc[db][r];
        if (tid < 128) Lsum[unit * 128 + tid] = lsum;
    }
}
#define RLX_AGENT __ATOMIC_RELAXED, __HIP_MEMORY_SCOPE_AGENT
#define XB_TMO      128
#define XB_XCNT(j)  (256  + 64 * (j))
#define XB_XSUB(j)  (1280 + 64 * (j))
#define XB_XGEN(j)  (2304 + 64 * (j))
#define XB_TOP      3328
#define XB_TOPGEN   3392
#define XCD_BAR_WORDS 3456
#define XB_SPIN_CAP (1u << 18)

__device__ __forceinline__ unsigned xb_ld(unsigned* p)              { return __hip_atomic_load(p, __ATOMIC_RELAXED, __HIP_MEMORY_SCOPE_AGENT); }
__device__ __forceinline__ unsigned xb_add(unsigned* p, unsigned v) { return __hip_atomic_fetch_add(p, v, __ATOMIC_RELAXED, __HIP_MEMORY_SCOPE_AGENT); }
__device__ __forceinline__ unsigned xb_xcc_id() { return (unsigned)__builtin_amdgcn_s_getreg((3 << 11) | 20) & 0xFu; }
#define XB_SPIN(cond, bar) do { unsigned _sp = 0; while (cond) { __builtin_amdgcn_s_sleep(1); \
    if ((++_sp & 255u) == 0u) { if (xb_ld(&(bar)[XB_TMO])) break; if (_sp > XB_SPIN_CAP) { atomicAdd(&(bar)[XB_TMO], 1u); break; } } } } while (0)

struct XcdBarrier {
    unsigned* bar; unsigned x;
    volatile LAS unsigned* st;
};

__device__ __forceinline__ XcdBarrier xcd_barrier_post(unsigned* bar, volatile LAS unsigned* st) {
    XcdBarrier b; b.bar = bar; b.x = xb_xcc_id(); b.st = st;
    if (threadIdx.x == 0) (void)xb_add(&bar[XB_XCNT(b.x)], 1u);
    return b;
}
__device__ __forceinline__ void xcd_barrier_complete(unsigned* bar, unsigned x, unsigned& nloc, unsigned& nx) {
    const unsigned G = gridDim.x * gridDim.y * gridDim.z;
    unsigned sum, cnt, mine, sp = 0u;
    for (;;) {
        sum = 0u; cnt = 0u; mine = 0u;
#pragma unroll
        for (unsigned j = 0; j < 16; ++j) { const unsigned c = xb_ld(&bar[XB_XCNT(j)]); sum += c; cnt += (c > 0u) ? 1u : 0u; mine = (j == x) ? c : mine; }
        if (sum == G) break;
        __builtin_amdgcn_s_sleep(1);
        if ((++sp & 255u) == 0u) { if (xb_ld(&bar[XB_TMO])) break; if (sp > XB_SPIN_CAP) { atomicAdd(&bar[XB_TMO], 1u); break; } }
    }
    nloc = mine > 0u ? mine : 1u; nx = cnt > 0u ? cnt : 1u;
}

__device__ __forceinline__ void xcd_barrier(const XcdBarrier& b) {
    asm volatile("s_waitcnt vmcnt(0)" ::: "memory");
    __syncthreads();
    if (threadIdx.x == 0) {
        unsigned* bar = b.bar;
        __builtin_amdgcn_s_waitcnt(0);
        unsigned nloc = b.st[0], nx = b.st[1];
        if (nloc == 0u) { xcd_barrier_complete(bar, b.x, nloc, nx); b.st[0] = nloc; b.st[1] = nx; }
        const unsigned old = xb_add(&bar[XB_XSUB(b.x)], 1u);
        const unsigned gen = old / nloc;
        if (old + 1u == (gen + 1u) * nloc) {
            __builtin_amdgcn_fence(__ATOMIC_RELEASE, "agent");
            asm volatile("s_waitcnt vmcnt(0)" ::: "memory");
            const unsigned og = xb_add(&bar[XB_TOP], 1u);
            const unsigned tg = og / nx;
            if (og + 1u == (tg + 1u) * nx) xb_add(&bar[XB_TOPGEN], 1u);
            else XB_SPIN(xb_ld(&bar[XB_TOPGEN]) == tg, bar);
            __builtin_amdgcn_fence(__ATOMIC_ACQUIRE, "agent");
            xb_add(&bar[XB_XGEN(b.x)], 1u);
            asm volatile("s_waitcnt vmcnt(0)" ::: "memory");
        } else {
            XB_SPIN(xb_ld(&bar[XB_XGEN(b.x)]) == gen, bar);
            __builtin_amdgcn_fence(__ATOMIC_ACQUIRE, "agent");
            asm volatile("s_waitcnt vmcnt(0)" ::: "memory");
        }
    }
    __syncthreads();
}

constexpr size_t DO_BAR = 107 * MiB;
constexpr int MISC_OFF = LDS_BYTES - 64;
__global__ void __launch_bounds__(NTHR, 2) fwd_megakernel(Args args) {
    extern __shared__ __attribute__((aligned(16))) unsigned char lds_raw[];
    cg::grid_group grid = cg::this_grid();
    LAS unsigned char* lds = (LAS unsigned char*)lds_raw;
    const int tid = threadIdx.x, lane = tid & 63, wave = __builtin_amdgcn_readfirstlane(tid >> 6);
    const int G = gridDim.x, bx = blockIdx.x;
    const float* x = args.in[0]; const float* cvec = args.in[1]; const float* w_ada = args.in[2]; const float* b_ada = args.in[3]; const float* w_in = args.in[4];
    const float* w_up = args.in[5]; const float* b_alpha = args.in[6]; const float* gng = args.in[7]; const float* w_out = args.in[8];
    const float* ln1_g = args.in[9]; const float* ln1_b = args.in[10]; const float* w_ffin = args.in[11]; const float* w_ffout = args.in[12]; const float* ln2_g = args.in[13]; const float* ln2_b = args.in[14];
    unsigned char* dsc = (unsigned char*)args.out;
    bf16* H = (bf16*)args.ws; float* Hf = (float*)args.ws;
    bf16* U1 = (bf16*)(dsc + DO_U1); bf16* Wt_in = (bf16*)(dsc + DO_WIN); bf16* Wt_out = (bf16*)(dsc + DO_WOUT); bf16* Wt_ffin = (bf16*)(dsc + DO_WFFIN); bf16* Wt_ffout = (bf16*)(dsc + DO_WFFOUT);
    bf16* GA = (bf16*)(dsc + DO_GA); float* Lst = (float*)(dsc + DO_U1); float* Lsum = (float*)(dsc + DO_U1 + 32 * MiB); float* modp = (float*)(dsc + DO_MODP); float* modf = (float*)(dsc + DO_MODF);

    volatile LAS unsigned* MISC = (volatile LAS unsigned*)(lds + MISC_OFF);
    if (tid < 16) MISC[tid] = 0u;
    __syncthreads();
    const XcdBarrier xbar = xcd_barrier_post((unsigned*)(dsc + DO_BAR), MISC);
    {
        LAS float* scr = (LAS float*)(lds + wave * 16384);
        const int gw = bx * NWAVES + wave, NGW = G * NWAVES;
        constexpr int I_ADA = 96 * 16, I_IN = (NIN / 32) * (D / 64), I_OUT = (D / 32) * (D / 64), I_FI = (2 * FF / 32) * (D / 64), I_FO = (D / 32) * (FF / 64);
        constexpr int NITEMS = I_ADA + I_IN + I_OUT + I_FI + I_FO;
        for (int it = gw; it < NITEMS; it += NGW) {
            int r = it;
            if (r < I_ADA) {
                const int cgp = r % 96, ks = r / 96, col = 64 * cgp + lane, k0 = 64 * ks;
                float sc[8], acc[8];
#pragma unroll
                for (int b = 0; b < 8; ++b) { const float cv = cvec[b * D + k0 + lane]; sc[b] = cv * sigmoidf_(cv); acc[b] = 0.f; }
#pragma unroll 8
                for (int kk = 0; kk < 64; ++kk) { const float w = w_ada[(size_t)(k0 + kk) * NMOD + col];
#pragma unroll
                    for (int b = 0; b < 8; ++b) acc[b] += __shfl(sc[b], kk) * w; }
#pragma unroll
                for (int b = 0; b < 8; ++b) modp[(size_t)(ks * 8 + b) * NMOD + col] = acc[b];
                continue;
            }
            r -= I_ADA;
            if (r < I_IN) { transpose_item(w_in, 8208, Wt_in, D, 32 * (r % (NIN / 32)), 64 * (r / (NIN / 32)), 0, false, scr, lane); continue; } r -= I_IN;
            if (r < I_OUT) { transpose_item(w_out, D, Wt_out, D, 32 * (r % (D / 32)), 64 * (r / (D / 32)), 2, false, scr, lane); continue; } r -= I_OUT;
            if (r < I_FI) { transpose_item(w_ffin, 2 * FF, Wt_ffin, D, 32 * (r % (2 * FF / 32)), 64 * (r / (2 * FF / 32)), 1, false, scr, lane); continue; } r -= I_FI;
            transpose_item(w_ffout, D, Wt_ffout, FF, 32 * (r % (D / 32)), 64 * (r / (D / 32)), 2, false, scr, lane);
        }
    }
    grid.sync();

    {
        for (int idx = bx * NTHR + tid; idx < BATCH * NMOD; idx += G * NTHR) { const int b = idx / NMOD, j = idx % NMOD; float s = b_ada[j];
#pragma unroll
            for (int ks = 0; ks < 16; ++ks) s += modp[(size_t)(ks * 8 + b) * NMOD + j];
            modf[idx] = s; }
        LAS float* ssh = (LAS float*)lds; LAS float* ssc = ssh + D;
        for (int rg = bx; rg < M / 128; rg += G) {
            const int b = rg / (SEQ / 128);
            __syncthreads();
            for (int j = tid; j < 2 * D; j += NTHR) { float s = b_ada[j];
#pragma unroll
                for (int ks = 0; ks < 16; ++ks) s += modp[(size_t)(ks * 8 + b) * NMOD + j];
                ssh[j] = s; }
            __syncthreads();
            for (int i = 0; i < 16; ++i) { const size_t row = (size_t)rg * 128 + wave * 16 + i;
                const f32x4* xr = (const f32x4*)(x + row * D) + lane; f32x4 v[4];
#pragma unroll
                for (int j = 0; j < 4; ++j) v[j] = xr[64 * j];
                float rstd; row_stats(v, rstd);
                unsigned long long* o8 = (unsigned long long*)(U1 + row * D) + lane;
#pragma unroll
                for (int j = 0; j < 4; ++j) { const int c0 = 4 * lane + 256 * j; const f32x4 sc = *(const LAS f32x4*)(ssc + c0), sh = *(const LAS f32x4*)(ssh + c0);
                    const f32x4 o = v[j] * rstd * (sc + 1.0f) + sh; o8[64 * j] = (unsigned long long)cvtpk(o.x, o.y) | ((unsigned long long)cvtpk(o.z, o.w) << 32); } }
        }
    }
    xcd_barrier(xbar);

    { pg8::Gemm g{U1, Wt_in, M, NIN, D, D}; pg8::StaticOrder S; S.init(M, NIN, G, bx); pg8::EpiH E{H, GA};
      pg8::gemm_phase<pg8::EpiH, pg8::StaticOrder, PG8_ALIGN, PG8_SP2>(lds, g, S, E); }
    xcd_barrier(xbar);

    {
        for (int unit = bx; unit < BATCH * 4 * GL_NSEG; unit += G) { if ((unit & 7) != 7) { int t_ = tid; asm volatile("" : "+v"(t_)); gla_seg<false>(H, GA, w_up, b_alpha, gng, Lst, Lsum, lds, unit, t_); } __syncthreads(); }
        LAS unsigned char* wl = lds + wave * (64 * SB_KS);
        for (int u = bx * NWAVES + wave; u < BATCH * 8 * (SEQ / 32); u += G * NWAVES) { const int qt = u & 127, bh = u >> 7; int l_ = lane; asm volatile("" : "+v"(l_)); sb_unit(H, wl, bh >> 3, bh & 7, qt, l_); }
    }
    xcd_barrier(xbar);
    for (int unit = bx; unit < BATCH * 4 * GL_NSEG; unit += G) { __syncthreads(); int t_ = tid; asm volatile("" : "+v"(t_)); gla_seg<true>(H, GA, w_up, b_alpha, gng, Lst, Lsum, lds, unit, t_); }
    xcd_barrier(xbar);

    { pg8::Gemm g{H + C_GG, Wt_out, M, D, D, HW}; pg8::StaticOrder S; S.init(M, D, G, bx); pg8::EpiRes E{x, D, Hf + F_R, HROWF, modf + 2 * D, ALPHA};
      pg8::gemm_phase<pg8::EpiRes, pg8::StaticOrder, PG8_ALIGN, PG8_SP2>(lds, g, S, E); }
    xcd_barrier(xbar);

    {
        LAS float* sg = (LAS float*)lds; LAS float* sb_ = sg + D; LAS float* ssh = sb_ + D; LAS float* ssc = ssh + D;
        for (int rg = bx; rg < M / 128; rg += G) {
            const int b = rg / (SEQ / 128);
            __syncthreads();
            for (int j = tid; j < D; j += NTHR) { sg[j] = ln1_g[j]; sb_[j] = ln1_b[j]; ssh[j] = modf[(size_t)b * NMOD + 3 * D + j]; ssc[j] = modf[(size_t)b * NMOD + 4 * D + j]; }
            __syncthreads();
            for (int i = 0; i < 16; ++i) { const size_t row = (size_t)rg * 128 + wave * 16 + i;
                const f32x4* rr = (const f32x4*)(Hf + row * HROWF + F_R) + lane; f32x4 v[4];
#pragma unroll
                for (int j = 0; j < 4; ++j) v[j] = rr[64 * j];
                float rstd; row_stats(v, rstd);
                f32x4* x1o = (f32x4*)(Hf + row * HROWF + F_X1) + lane;
#pragma unroll
                for (int j = 0; j < 4; ++j) { const int c0 = 4 * lane + 256 * j; v[j] = v[j] * rstd * *(const LAS f32x4*)(sg + c0) + *(const LAS f32x4*)(sb_ + c0); x1o[64 * j] = v[j]; }
                row_stats(v, rstd);
                unsigned long long* o8 = (unsigned long long*)(H + row * HW + C_U2) + lane;
#pragma unroll
                for (int j = 0; j < 4; ++j) { const int c0 = 4 * lane + 256 * j; const f32x4 o = v[j] * rstd * (*(const LAS f32x4*)(ssc + c0) + 1.0f) + *(const LAS f32x4*)(ssh + c0);
                    o8[64 * j] = (unsigned long long)cvtpk(o.x, o.y) | ((unsigned long long)cvtpk(o.z, o.w) << 32); } }
        }
    }
    xcd_barrier(xbar);

    { pg8::Gemm g{H + C_U2, Wt_ffin, M, 2 * FF, D, HW}; pg8::StaticOrder S; S.init(M, 2 * FF, G, bx); pg8::EpiSwiglu E{H + C_ACT, HW};
      pg8::gemm_phase<pg8::EpiSwiglu, pg8::StaticOrder, PG8_ALIGN, PG8_SP2>(lds, g, S, E); }
    xcd_barrier(xbar);

    { pg8::Gemm g{H + C_ACT, Wt_ffout, M, D, FF, HW}; pg8::StaticOrder S; S.init(M, D, G, bx); pg8::EpiRes E{Hf + F_X1, HROWF, Hf + F_R, HROWF, modf + 5 * D, ALPHA};
      pg8::gemm_phase<pg8::EpiRes, pg8::StaticOrder, PG8_ALIGN, PG8_SP2>(lds, g, S, E); }
    grid.sync();

    {
        for (size_t row = (size_t)bx * NWAVES + wave; row < (size_t)M; row += (size_t)G * NWAVES) {
            const f32x4* rr = (const f32x4*)(Hf + row * HROWF + F_R) + lane; f32x4 v[4];
#pragma unroll
            for (int j = 0; j < 4; ++j) v[j] = rr[64 * j];
            float rstd; row_stats(v, rstd);
            f32x4* oo = (f32x4*)(args.out + row * D) + lane;
#pragma unroll
            for (int j = 0; j < 4; ++j) { const int c0 = 4 * lane + 256 * j; oo[64 * j] = v[j] * rstd * *(const f32x4*)(ln2_g + c0) + *(const f32x4*)(ln2_b + c0); }
        }
    }
}

extern "C" void kernel_launch(void* const* d_in, const int* in_sizes, int n_in, void* d_out, int out_size, void* d_ws, size_t ws_size, hipStream_t stream) {
    static int grid = 0;
    if (grid == 0) {
        if (n_in != 15 || out_size != M * D || ws_size < (size_t)M * HW * 2) { fprintf(stderr, "kernel_launch: unexpected problem shape (n_in %d, out %d, ws %zu)\n", n_in, out_size, ws_size); grid = -1; return; }
        int dev = 0, cus = 0, per_cu = 0;
        if (hipGetDevice(&dev) != hipSuccess || hipDeviceGetAttribute(&cus, hipDeviceAttributeMultiprocessorCount, dev) != hipSuccess) { grid = -1; return; }
        if (hipFuncSetAttribute((const void*)fwd_megakernel, hipFuncAttributeMaxDynamicSharedMemorySize, LDS_BYTES) != hipSuccess) { fprintf(stderr, "kernel_launch: hipFuncSetAttribute failed\n"); grid = -1; return; }
        if (hipOccupancyMaxActiveBlocksPerMultiprocessor(&per_cu, (const void*)fwd_megakernel, NTHR, LDS_BYTES) != hipSuccess || per_cu < 1) { fprintf(stderr, "kernel_launch: occupancy query gave %d\n", per_cu); per_cu = 1; }
        (void)hipGetLastError();
        grid = cus * per_cu;
    }
    if (grid < 0) return;
    if (hipMemsetAsync((char*)d_out + DO_BAR, 0, 16384, stream) != hipSuccess) { fprintf(stderr, "kernel_launch: memset failed\n"); return; }
    Args a{};
    for (int i = 0; i < 15; ++i) a.in[i] = (const float*)d_in[i];
    a.out = (float*)d_out; a.ws = (unsigned char*)d_ws;
    void* kargs[] = {&a};
    const hipError_t e = hipLaunchCooperativeKernel((const void*)fwd_megakernel, dim3(grid), dim3(NTHR), kargs, LDS_BYTES, stream);
    if (e != hipSuccess) fprintf(stderr, "kernel_launch: cooperative launch failed: %s (grid %d)\n", hipGetErrorString(e), grid);
}
```

```cpp
#include <hip/hip_runtime.h>
#include <hip/hip_cooperative_groups.h>
#include <cstdio>
#include <cstdint>
namespace cg = cooperative_groups;
namespace pg8 {
#define PG8_LAS __attribute__((address_space(3)))
typedef unsigned short bf16_t;
typedef short bf16x8 __attribute__((ext_vector_type(8)));
typedef float f32x4 __attribute__((ext_vector_type(4)));
typedef unsigned u32x4 __attribute__((ext_vector_type(4)));
constexpr int BM = 256, BK = 64, HALF = 128, HTB = HALF * BK * 2  , STAGE_BYTES = 8 * HTB, NXCD = 8, WGM = 8;

__host__ __device__ __forceinline__ int lds_byte(int r, int c) { const int st = (r >> 4) * 2 + (c >> 5), rr = r & 15, cc = c & 31, ob = rr * 64 + cc * 2; return st * 1024 + (ob ^ (((ob >> 9) & 1) << 5)); }
__host__ __device__ __forceinline__ void stage_rc(int b, int& R, int& C) { const int st = b / 1024, sb = b % 1024, swz = sb ^ (((sb >> 9) & 1) << 5); R = (st >> 1) * 16 + swz / 64; C = (st & 1) * 32 + (swz % 64) / 2; }
__host__ __device__ __forceinline__ int perm32(int rho) { const int n = rho >> 4, i = rho & 15; return 8 * (i >> 2) + 4 * n + (i & 3); }

struct Unit { int pm, pn; };
struct Gemm { const bf16_t* A; const bf16_t* Bt; int M, N, K, lda; };

struct StaticOrder {
    int nM, nN, nwg, G, c;
    __host__ __device__ void init(int M, int N, int G_, int c_) { nM = M / BM; nN = N / BM; nwg = nM * nN; G = G_; c = c_; }
    __host__ __device__ bool next(int i, Unit& u) const {
        const long L = (long)i * G + c; if (L >= nwg) return false;
        int wgid = (int)L; { const int q = nwg / NXCD, r = nwg % NXCD, xcd = wgid % NXCD, off = wgid / NXCD; wgid = (xcd < r ? xcd * (q + 1) : r * (q + 1) + (xcd - r) * q) + off; }
        const int nig = WGM * nN, gid = wgid / nig, fm = gid * WGM, gsz = (nM - fm) < WGM ? (nM - fm) : WGM;
        u.pm = fm + ((wgid % nig) % gsz); u.pn = (wgid % nig) / gsz; return true;
    }
    __device__ __forceinline__ void a_ready(const Unit&) const {}
    __device__ __forceinline__ void done(const Unit&) const {}
};

__device__ __forceinline__ unsigned cvt_pk_bf16(float lo, float hi) { unsigned r; asm volatile("v_cvt_pk_bf16_f32 %0, %1, %2" : "=v"(r) : "v"(lo), "v"(hi)); return r; }
typedef __bf16 bf16x2_t __attribute__((ext_vector_type(2)));
typedef float f32x2_t __attribute__((ext_vector_type(2)));
typedef unsigned u32x2 __attribute__((ext_vector_type(2)));
__device__ __forceinline__ unsigned cvtpk(float lo, float hi) { f32x2_t v = {lo, hi}; bf16x2_t b = __builtin_convertvector(v, bf16x2_t); return __builtin_bit_cast(unsigned, b); }

struct EpiH {
    static constexpr bool PERM = true, AFTER_DRAIN = false;
    bf16_t* H; bf16_t* GA;
    __device__ __forceinline__ void operator()(const f32x4 (&acc)[2][2][4][2], const Unit& u, int wr, int wc, int fr, int fq) const {
        const int row0 = u.pm * BM + wr * 64 + fr;
        if (u.pn < 32) {
            const int col0 = u.pn * BM + wc * 32 + 8 * fq;
#pragma unroll
            for (int ai = 0; ai < 2; ++ai)
#pragma unroll
                for (int m = 0; m < 4; ++m) { bf16_t* rowp = H + (size_t)(row0 + ai * HALF + m * 16) * 8192 + col0;
#pragma unroll
                    for (int bj = 0; bj < 2; ++bj) { const f32x4 v0 = acc[ai][bj][m][0], v1 = acc[ai][bj][m][1];
                        u32x4 w; w.x = cvtpk(v0[0], v0[1]); w.y = cvtpk(v0[2], v0[3]); w.z = cvtpk(v1[0], v1[1]); w.w = cvtpk(v1[2], v1[3]);
                        *(u32x4*)(rowp + bj * HALF) = w; } }
        } else if (wc == 0 && fq < 2) {
#pragma unroll
            for (int ai = 0; ai < 2; ++ai)
#pragma unroll
                for (int m = 0; m < 4; ++m) { const f32x4 v0 = acc[ai][0][m][0], v1 = acc[ai][0][m][1];
                    u32x4 w; w.x = cvtpk(v0[0], v0[1]); w.y = cvtpk(v0[2], v0[3]); w.z = cvtpk(v1[0], v1[1]); w.w = cvtpk(v1[2], v1[3]);
                    *(u32x4*)(GA + (size_t)(row0 + ai * HALF + m * 16) * 16 + 8 * fq) = w; }
        }
    }
};
struct EpiRes {
    static constexpr bool PERM = false, AFTER_DRAIN = false;
    const float* X; int ldx; float* O; int ldo; const float* gate; float alpha;
    __device__ __forceinline__ void operator()(const f32x4 (&acc)[2][2][4][2], const Unit& u, int wr, int wc, int fr, int fq) const {
        const int b = u.pm >> 4; const int col0 = u.pn * BM + wc * 32 + 4 * fq;
#pragma unroll
        for (int bj = 0; bj < 2; ++bj)
#pragma unroll
            for (int n = 0; n < 2; ++n) { const int c = col0 + bj * HALF + n * 16; const f32x4 gv = *(const f32x4*)(gate + (size_t)b * 6144 + c) + 1.0f;
#pragma unroll
                for (int ai = 0; ai < 2; ++ai)
#pragma unroll
                    for (int m = 0; m < 4; ++m) { const size_t r = (size_t)(u.pm * BM + ai * HALF + wr * 64 + m * 16 + fr);
                        const f32x4 xv = *(const f32x4*)(X + r * ldx + c); *(f32x4*)(O + r * ldo + c) = xv * alpha + gv * acc[ai][bj][m][n]; } }
    }
};
struct EpiSwiglu {
    static constexpr bool PERM = true, AFTER_DRAIN = false;
    bf16_t* O; int ldo;
    __device__ __forceinline__ void operator()(const f32x4 (&acc)[2][2][4][2], const Unit& u, int wr, int wc, int fr, int fq) const {
        const int row0 = u.pm * BM + wr * 64 + fr; const int col0 = u.pn * HALF + wc * 32 + 8 * fq;
#pragma unroll
        for (int ai = 0; ai < 2; ++ai)
#pragma unroll
            for (int m = 0; m < 4; ++m) { float a[8];
#pragma unroll
                for (int n = 0; n < 2; ++n)
#pragma unroll
                    for (int j = 0; j < 4; ++j) { const float g = acc[ai][0][m][n][j], up = acc[ai][1][m][n][j]; a[4 * n + j] = g * __builtin_amdgcn_rcpf(1.0f + __builtin_amdgcn_exp2f(-g * 1.4426950408889634f)) * up; }
                u32x4 w; w.x = cvtpk(a[0], a[1]); w.y = cvtpk(a[2], a[3]); w.z = cvtpk(a[4], a[5]); w.w = cvtpk(a[6], a[7]);
                *(u32x4*)(O + (size_t)(row0 + ai * HALF + m * 16) * ldo + col0) = w; }
    }
};

template <class Epi, class Sched, bool ALIGN_EPI = false, bool SP2 = false>
__device__ __forceinline__ void gemm_phase(PG8_LAS unsigned char* lds, const Gemm g, const Sched& S, const Epi& E) {
    int tid_ = threadIdx.x; asm volatile("" : "+v"(tid_));
    const int tid = tid_, wid = __builtin_amdgcn_readfirstlane(tid >> 6), lane = tid & 63, wr = wid >> 2, wc = wid & 3, fr = lane & 15, fq = lane >> 4;
    const int K = g.K, nt = K / BK;
    unsigned voffA[2], voffB[2];
#pragma unroll
    for (int i = 0; i < 2; ++i) { int R, C; stage_rc(tid * 16 + i * 8192, R, C); const int Rb = Epi::PERM ? ((R & ~31) + perm32(R & 31)) : R;
        voffA[i] = (unsigned)(R * g.lda + C) * 2u; voffB[i] = (unsigned)(Rb * K + C) * 2u; }
    const size_t kstep = (size_t)(BK * 2);
    const size_t hstepA = (size_t)HALF * g.lda * 2, hstepB = (size_t)HALF * K * 2;
    const size_t tstepA = 2 * hstepA, tstepB = 2 * hstepB;
    const unsigned ldsw = (unsigned)wid * 1024u;
    const int aoff = lds_byte(wr * 64 + fr, fq * 8), boff = lds_byte(wc * 32 + fr, fq * 8);
#define PG8_SA(b, h) (((b) * 2 + (h)) * HTB)
#define PG8_SB(b, h) ((4 + (b) * 2 + (h)) * HTB)
#define PG8_STAGE(bufoff, gbase, voff) do { _Pragma("unroll") for (int _i = 0; _i < 2; ++_i) \
        __builtin_amdgcn_global_load_lds((const unsigned*)((const char*)(gbase) + (voff)[_i]), (PG8_LAS unsigned*)(lds + (bufoff) + ldsw + _i * 8192), 16, 0, 0); } while (0)
#define PG8_LDA(dst, b, h) do { _Pragma("unroll") for (int m = 0; m < 4; ++m) _Pragma("unroll") for (int k = 0; k < 2; ++k) dst[m][k] = *(const PG8_LAS bf16x8*)(lds + PG8_SA(b, h) + aoff + m * 2048 + k * 1024); } while (0)
#define PG8_LDB(dst, b, h) do { _Pragma("unroll") for (int n = 0; n < 2; ++n) _Pragma("unroll") for (int k = 0; k < 2; ++k) dst[n][k] = *(const PG8_LAS bf16x8*)(lds + PG8_SB(b, h) + boff + n * 2048 + k * 1024); } while (0)
#define PG8_MMA(ai, bj, At, Bt) do { __builtin_amdgcn_s_setprio(1); _Pragma("unroll") for (int m = 0; m < 4; ++m) _Pragma("unroll") for (int n = 0; n < 2; ++n) _Pragma("unroll") for (int k = 0; k < 2; ++k) \
        acc[ai][bj][m][n] = __builtin_amdgcn_mfma_f32_16x16x32_bf16(Bt[n][k], At[m][k], acc[ai][bj][m][n], 0, 0, 0); __builtin_amdgcn_s_setprio(0); } while (0)
#define PG8_WAIT_V(n) asm volatile("s_waitcnt vmcnt(" #n ")" ::: "memory")
#define PG8_WAIT_L(n) asm volatile("s_waitcnt lgkmcnt(" #n ")" ::: "memory")
#define PG8_BAR __builtin_amdgcn_s_barrier()
#define PG8_SCHED __builtin_amdgcn_sched_barrier(0)
    Unit cur, nxt; int ui = 0;
    if (!S.next(0, cur)) return;
    f32x4 acc[2][2][4][2];
#pragma unroll
    for (int a = 0; a < 2; ++a)
#pragma unroll
        for (int b = 0; b < 2; ++b)
#pragma unroll
            for (int m = 0; m < 4; ++m)
#pragma unroll
                for (int n = 0; n < 2; ++n) acc[a][b][m][n] = (f32x4){0.f, 0.f, 0.f, 0.f};
    bf16x8 At[4][2], B0[2][2], B1[2][2];
    const char* cA = (const char*)g.A + (size_t)cur.pm * tstepA; const char* cB = (const char*)g.Bt + (size_t)cur.pn * tstepB;
    S.a_ready(cur);
    if constexpr (SP2) {
        PG8_STAGE(PG8_SB(0, 0), cB, voffB); PG8_STAGE(PG8_SB(0, 1), cB + hstepB, voffB); PG8_STAGE(PG8_SA(0, 0), cA, voffA); PG8_STAGE(PG8_SA(0, 1), cA + hstepA, voffA);
        if (wr == 1) PG8_BAR;
        PG8_WAIT_V(2); PG8_BAR;
        PG8_STAGE(PG8_SB(1, 0), cB + kstep, voffB); PG8_STAGE(PG8_SA(1, 0), cA + kstep, voffA); PG8_STAGE(PG8_SB(1, 1), cB + hstepB + kstep, voffB);
        PG8_WAIT_V(6); PG8_BAR;
    } else {
        PG8_STAGE(PG8_SB(0, 0), cB, voffB); PG8_STAGE(PG8_SA(0, 0), cA, voffA); PG8_STAGE(PG8_SB(0, 1), cB + hstepB, voffB); PG8_STAGE(PG8_SA(0, 1), cA + hstepA, voffA);
        if (wr == 1) PG8_BAR;
        PG8_WAIT_V(4); PG8_BAR;
        PG8_STAGE(PG8_SB(1, 0), cB + kstep, voffB); PG8_STAGE(PG8_SA(1, 0), cA + kstep, voffA); PG8_STAGE(PG8_SB(1, 1), cB + hstepB + kstep, voffB);
        PG8_WAIT_V(6); PG8_BAR;
    }
    for (;;) {
        const bool has_next = S.next(ui + 1, nxt);
        const char* nA = has_next ? (const char*)g.A + (size_t)nxt.pm * tstepA : cA; const char* nB = has_next ? (const char*)g.Bt + (size_t)nxt.pn * tstepB : cB;
        for (int t = 0; t < nt; t += 2) {
            const bool last = (t == nt - 2);
            const char* a1 = cA + (size_t)(t + 1) * kstep;
            const char* a2 = last ? nA : cA + (size_t)(t + 2) * kstep; const char* b2 = last ? nB : cB + (size_t)(t + 2) * kstep;
            const char* a3 = a2 + kstep; const char* b3 = b2 + kstep;
            if (last && has_next) S.a_ready(nxt);
            if constexpr (SP2) {
            PG8_LDB(B0, 0, 0); PG8_LDB(B1, 0, 1); PG8_SCHED; PG8_LDA(At, 0, 0); PG8_STAGE(PG8_SA(1, 1), a1 + hstepA, voffA);
            PG8_WAIT_V(8); PG8_WAIT_L(0); PG8_BAR; PG8_MMA(0, 0, At, B0); PG8_MMA(0, 1, At, B1); PG8_BAR; PG8_SCHED;
            PG8_LDA(At, 0, 1); PG8_STAGE(PG8_SB(0, 0), b2, voffB); PG8_STAGE(PG8_SB(0, 1), b2 + hstepB, voffB); PG8_STAGE(PG8_SA(0, 0), a2, voffA);
            PG8_WAIT_V(8); PG8_WAIT_L(0); PG8_BAR; PG8_MMA(1, 0, At, B0); PG8_MMA(1, 1, At, B1); PG8_BAR; PG8_SCHED;
            PG8_LDB(B0, 1, 0); PG8_LDB(B1, 1, 1); PG8_SCHED; PG8_LDA(At, 1, 0); PG8_STAGE(PG8_SA(0, 1), a2 + hstepA, voffA);
            PG8_WAIT_V(8); PG8_WAIT_L(0); PG8_BAR; PG8_MMA(0, 0, At, B0); PG8_MMA(0, 1, At, B1); PG8_BAR; PG8_SCHED;
            PG8_LDA(At, 1, 1); PG8_STAGE(PG8_SB(1, 0), b3, voffB); PG8_STAGE(PG8_SB(1, 1), b3 + hstepB, voffB); PG8_STAGE(PG8_SA(1, 0), a3, voffA);
            PG8_WAIT_V(8); PG8_WAIT_L(0); PG8_BAR; PG8_MMA(1, 0, At, B0); PG8_MMA(1, 1, At, B1); PG8_BAR; PG8_SCHED;
            } else {
            PG8_LDB(B0, 0, 0); PG8_SCHED; PG8_LDA(At, 0, 0); PG8_STAGE(PG8_SA(1, 1), a1 + hstepA, voffA);
            PG8_WAIT_L(8); PG8_BAR; PG8_WAIT_L(0); PG8_MMA(0, 0, At, B0); PG8_BAR; PG8_SCHED;
            PG8_LDB(B1, 0, 1); PG8_STAGE(PG8_SB(0, 0), b2, voffB);
            PG8_BAR; PG8_WAIT_L(0); PG8_MMA(0, 1, At, B1); PG8_BAR;
            PG8_LDA(At, 0, 1); PG8_STAGE(PG8_SA(0, 0), a2, voffA);
            PG8_BAR; PG8_WAIT_L(0); PG8_MMA(1, 0, At, B0); PG8_BAR; PG8_SCHED;
            PG8_STAGE(PG8_SB(0, 1), b2 + hstepB, voffB);
            PG8_WAIT_V(6); PG8_BAR; PG8_MMA(1, 1, At, B1); PG8_BAR;
            PG8_LDB(B0, 1, 0); PG8_SCHED; PG8_LDA(At, 1, 0); PG8_STAGE(PG8_SA(0, 1), a2 + hstepA, voffA);
            PG8_WAIT_L(8); PG8_BAR; PG8_WAIT_L(0); PG8_MMA(0, 0, At, B0); PG8_BAR; PG8_SCHED;
            PG8_LDB(B1, 1, 1); PG8_STAGE(PG8_SB(1, 0), b3, voffB);
            PG8_BAR; PG8_WAIT_L(0); PG8_MMA(0, 1, At, B1); PG8_BAR;
            PG8_LDA(At, 1, 1); PG8_STAGE(PG8_SA(1, 0), a3, voffA);
            PG8_BAR; PG8_WAIT_L(0); PG8_MMA(1, 0, At, B0); PG8_BAR; PG8_SCHED;
            PG8_STAGE(PG8_SB(1, 1), b3 + hstepB, voffB);
            PG8_WAIT_V(6); PG8_BAR; PG8_MMA(1, 1, At, B1); PG8_BAR;
            }
        }
        if constexpr (ALIGN_EPI) { if (wr == 0) PG8_BAR; }
        if constexpr (!Epi::AFTER_DRAIN) { E(acc, cur, wr, wc, fr, fq); S.done(cur); }
        if (!has_next) break;
#pragma unroll
        for (int a = 0; a < 2; ++a)
#pragma unroll
            for (int b = 0; b < 2; ++b)
#pragma unroll
                for (int m = 0; m < 4; ++m)
#pragma unroll
                    for (int n = 0; n < 2; ++n) acc[a][b][m][n] = (f32x4){0.f, 0.f, 0.f, 0.f};
        cur = nxt; cA = nA; cB = nB; ++ui;
        if constexpr (ALIGN_EPI) { if (wr == 1) PG8_BAR; }
    }
    PG8_WAIT_V(0);
    if constexpr (!ALIGN_EPI) { if (wr == 0) PG8_BAR; }
    PG8_BAR;
    if constexpr (Epi::AFTER_DRAIN) { E.fused(acc, cur, wr, wc, fr, fq, lds, wid, lane); S.done(cur); }
#undef PG8_SA
#undef PG8_SB
#undef PG8_STAGE
#undef PG8_LDA
#undef PG8_LDB
#undef PG8_MMA
#undef PG8_WAIT_V
#undef PG8_WAIT_L
#undef PG8_BAR
#undef PG8_SCHED
}
}
#ifndef PG8_SP2
#define PG8_SP2 true
#endif
#ifndef PG8_ALIGN
#define PG8_ALIGN true
#endif
#define LAS __attribute__((address_space(3)))
typedef unsigned short bf16;
typedef short bf16x8 __attribute__((ext_vector_type(8)));
typedef short s16x4 __attribute__((ext_vector_type(4)));
typedef float f32x4 __attribute__((ext_vector_type(4)));
typedef float f32x16 __attribute__((ext_vector_type(16)));
typedef unsigned v4u __attribute__((ext_vector_type(4)));
typedef unsigned v2u __attribute__((ext_vector_type(2)));
using pg8::cvtpk;
constexpr int NWAVES = 8, NTHR = 512;
constexpr int BATCH = 8, SEQ = 4096, D = 1024, M = BATCH * SEQ, FF = 2816, NMOD = 6 * D;
constexpr int HW = 8192;
constexpr int C_GQ = 0, C_GK = 512, C_GV = 1024, C_GG = 2048, C_SQ = 3072, C_SK = 4096, C_SV = 5120, C_MA = 6144, C_MB = 7168;
constexpr int NIN = 8448;
constexpr int C_U2 = 0, C_ACT = 1024;
constexpr int HROWF = 4096, F_R = 2048, F_X1 = 3072;
constexpr float LN_EPS = 1e-5f, ALPHA = 1.189207115002721f;
constexpr float QK_SCALE = 0.08838834764831845f;
constexpr size_t MiB = 1u << 20;
constexpr size_t DO_U1 = 0, DO_WIN = 64 * MiB, DO_WOUT = 81 * MiB, DO_WFFIN = 85 * MiB, DO_WFFOUT = 96 * MiB, DO_GA = 102 * MiB, DO_MODP = 103 * MiB, DO_MODF = 106 * MiB;
static_assert(DO_WIN + (size_t)NIN * D * 2 <= DO_WOUT && DO_WOUT + (size_t)D * 2048 * 2 <= DO_WFFIN && DO_WFFIN + (size_t)2 * FF * D * 2 <= DO_WFFOUT && DO_WFFOUT + (size_t)D * FF * 2 <= DO_GA &&
              DO_GA + (size_t)M * 16 * 2 <= DO_MODP && DO_MODP + (size_t)16 * BATCH * NMOD * 4 <= DO_MODF && DO_MODF + (size_t)BATCH * NMOD * 4 <= 128 * MiB, "d_out scratch map");
constexpr int LDS_BYTES = 147456;

__device__ __forceinline__ float bf2f(unsigned short u) { return __uint_as_float((unsigned)u << 16); }
__device__ __forceinline__ float wave_sum(float v) {
#pragma unroll
    for (int o = 1; o < 64; o <<= 1) v += __shfl_xor(v, o);
    return v;
}
__device__ __forceinline__ int crow(int reg, int h) { return (reg & 3) + 8 * (reg >> 2) + 4 * h; }
#define MFMA32(a, b, c) __builtin_amdgcn_mfma_f32_32x32x16_bf16((a), (b), (c), 0, 0, 0)
__device__ __forceinline__ bf16x8 pack8(float a0, float a1, float a2, float a3, float a4, float a5, float a6, float a7) {
    v4u p; p.x = cvtpk(a0, a1); p.y = cvtpk(a2, a3); p.z = cvtpk(a4, a5); p.w = cvtpk(a6, a7); return __builtin_bit_cast(bf16x8, p);
}
#define PACK_STEP(x, s) pack8((x)[8 * (s)], (x)[8 * (s) + 1], (x)[8 * (s) + 2], (x)[8 * (s) + 3], (x)[8 * (s) + 4], (x)[8 * (s) + 5], (x)[8 * (s) + 6], (x)[8 * (s) + 7])
typedef short v4i16_t __attribute__((ext_vector_type(4)));
__device__ __forceinline__ s16x4 trd(const LAS unsigned char* p) { return __builtin_bit_cast(s16x4, __builtin_amdgcn_ds_read_tr16_b64_v4i16((LAS v4i16_t*)p)); }
__device__ __forceinline__ bf16x8 trfrag(const LAS unsigned char* p, int stride8) { const s16x4 lo = trd(p), hi = trd(p + stride8); return __builtin_shufflevector(lo, hi, 0, 1, 2, 3, 4, 5, 6, 7); }
constexpr float LOG2E = 1.4426950408889634f;
__device__ __forceinline__ float ex2(float x) { return __builtin_amdgcn_exp2f(x); }
__device__ __forceinline__ float lg2(float x) { return __builtin_amdgcn_logf(x); }
__device__ __forceinline__ float sigmoidf_(float x) { return __builtin_amdgcn_rcpf(1.0f + ex2(-x * LOG2E)); }
__device__ __forceinline__ float softplus2(float z2) { return fmaxf(z2, 0.f) + lg2(1.0f + ex2(-fabsf(z2))); }

__device__ __forceinline__ void transpose_item(const float* W, int Nsrc, bf16* WT, int ldw, int d0, int k0, int map, bool dup, LAS float* scr, int lane) {
    const int d = d0 + (lane & 31); int sc;
    if (map == 0) sc = d < 3072 ? d : (d < 8192 ? d + 16 : (d < 8208 ? 3072 + (d - 8192) : -1));
    else if (map == 1) { const int pn = d >> 8, j = d & 255; sc = j < 128 ? 128 * pn + j : FF + 128 * pn + (j - 128); }
    else sc = d;
#pragma unroll 8
    for (int i = 0; i < 32; ++i) { const int kk = 2 * i + (lane >> 5); scr[kk * 33 + (lane & 31)] = sc >= 0 ? W[(size_t)(k0 + kk) * Nsrc + sc] : 0.f; }
    asm volatile("s_waitcnt lgkmcnt(0)" ::: "memory");
    const int c = lane & 7;
#pragma unroll
    for (int j = 0; j < 4; ++j) { const int n = (lane >> 3) + 8 * j; const LAS float* s = scr + (8 * c) * 33 + n;
        v4u o; o.x = cvtpk(s[0 * 33], s[1 * 33]); o.y = cvtpk(s[2 * 33], s[3 * 33]); o.z = cvtpk(s[4 * 33], s[5 * 33]); o.w = cvtpk(s[6 * 33], s[7 * 33]);
        bf16* dst = WT + (size_t)(d0 + n) * ldw + k0 + 8 * c; *(v4u*)dst = o; if (dup) *(v4u*)(dst + 1024) = o; }
    asm volatile("s_waitcnt lgkmcnt(0)" ::: "memory");
}

struct Args { const float* in[15]; float* out; unsigned char* ws; };

__device__ __forceinline__ void row_stats(f32x4 (&v)[4], float& rstd) {
    float s = 0.f;
#pragma unroll
    for (int j = 0; j < 4; ++j) s += (v[j].x + v[j].y) + (v[j].z + v[j].w);
    const float mean = wave_sum(s) * (1.f / D); float s2 = 0.f;
#pragma unroll
    for (int j = 0; j < 4; ++j) { v[j] = v[j] - mean; s2 += (v[j].x * v[j].x + v[j].y * v[j].y) + (v[j].z * v[j].z + v[j].w * v[j].w); }
    rstd = 1.0f / sqrtf(wave_sum(s2) * (1.f / D) + LN_EPS);
}

constexpr int SB_KS = 272;
__device__ __forceinline__ void sb_unit(bf16* H, LAS unsigned char* wl, int b, int hd, int qt, int lane) {
    const int n = lane & 31, hh = lane >> 5, i16 = lane & 15, tq = i16 >> 2, tp = i16 & 3, blk = (lane >> 4) & 1;
    const size_t rowbase = (size_t)b * SEQ;
    bf16x8 qf[8];
    { const bf16* qp = H + (rowbase + 32 * qt + n) * HW + C_SQ + hd * 128 + 8 * hh;
#pragma unroll
      for (int s = 0; s < 8; ++s) qf[s] = *(const bf16x8*)(qp + 16 * s); }
    f32x16 oT[4];
#pragma unroll
    for (int cb = 0; cb < 4; ++cb)
#pragma unroll
        for (int r = 0; r < 16; ++r) oT[cb][r] = 0.f;
    float R = 0.f;
    LAS unsigned char* Kl = wl; LAS unsigned char* Vl = wl + 32 * SB_KS;
    const LAS unsigned char* kread = Kl + n * SB_KS + 16 * hh;
    const LAS unsigned char* vread = Vl + (4 * hh + tq) * SB_KS + (16 * blk + 4 * tp) * 2;
    v4u kreg[8], vreg[8];
    { const bf16* kp = H + (rowbase + 32 * qt) * HW + C_SK + hd * 128; const bf16* vp = kp + (C_SV - C_SK);
#pragma unroll
      for (int i = 0; i < 8; ++i) { const int id = lane + 64 * i, row = id >> 4, ch = id & 15; kreg[i] = *(const v4u*)(kp + (size_t)row * HW + ch * 8); vreg[i] = *(const v4u*)(vp + (size_t)row * HW + ch * 8); } }
    for (int kt = qt; kt >= 0; --kt) {
#pragma unroll
        for (int i = 0; i < 8; ++i) { const int id = lane + 64 * i, row = id >> 4, ch = id & 15;
            *(LAS v4u*)(Kl + row * SB_KS + ch * 16) = kreg[i]; *(LAS v4u*)(Vl + row * SB_KS + ch * 16) = vreg[i]; }
        if (kt > 0) { const bf16* kp = H + (rowbase + 32 * (kt - 1)) * HW + C_SK + hd * 128; const bf16* vp = kp + (C_SV - C_SK);
#pragma unroll
            for (int i = 0; i < 8; ++i) { const int id = lane + 64 * i, row = id >> 4, ch = id & 15; kreg[i] = *(const v4u*)(kp + (size_t)row * HW + ch * 8); vreg[i] = *(const v4u*)(vp + (size_t)row * HW + ch * 8); } }
        f32x16 st, st1;
#pragma unroll
        for (int r = 0; r < 16; ++r) { st[r] = 0.f; st1[r] = 0.f; }
#pragma unroll
        for (int s = 0; s < 8; s += 2) { const bf16x8 kf = *(const LAS bf16x8*)(kread + 32 * s), kf1 = *(const LAS bf16x8*)(kread + 32 * s + 32); st = MFMA32(kf, qf[s], st); st1 = MFMA32(kf1, qf[s + 1], st1); }
#pragma unroll
        for (int r = 0; r < 16; ++r) st[r] += st1[r];
        const bool diag = (kt == qt);
        float sp[16], w[16];
#pragma unroll
        for (int r = 0; r < 16; ++r) { const float z = st[r] * (QK_SCALE * LOG2E); const float spv = softplus2(z); const bool valid = !diag || (crow(r, hh) < n);
            sp[r] = valid ? spv : 0.f; w[r] = valid ? (z - spv) : -1.0e30f; }
        float own[4], par[4];
#pragma unroll
        for (int g = 0; g < 4; ++g) own[g] = (sp[4 * g] + sp[4 * g + 1]) + (sp[4 * g + 2] + sp[4 * g + 3]);
#pragma unroll
        for (int g = 0; g < 4; ++g) par[g] = __shfl_xor(own[g], 32);
        float U[4];
        U[3] = 0.f; U[2] = own[3] + par[3]; U[1] = U[2] + (own[2] + par[2]); U[0] = U[1] + (own[1] + par[1]);
        const float total = U[0] + (own[0] + par[0]);
#pragma unroll
        for (int g = 0; g < 4; ++g) { float after = R + U[g] + (hh == 0 ? par[g] : 0.f);
            w[4 * g + 3] = ex2(w[4 * g + 3] - after); after += sp[4 * g + 3];
            w[4 * g + 2] = ex2(w[4 * g + 2] - after); after += sp[4 * g + 2];
            w[4 * g + 1] = ex2(w[4 * g + 1] - after); after += sp[4 * g + 1];
            w[4 * g] = ex2(w[4 * g] - after); }
        R += total;
        const bf16x8 wf0 = pack8(w[0], w[1], w[2], w[3], w[4], w[5], w[6], w[7]), wf1 = pack8(w[8], w[9], w[10], w[11], w[12], w[13], w[14], w[15]);
#pragma unroll
        for (int cb = 0; cb < 4; ++cb) {
            const bf16x8 v0 = trfrag(vread + 64 * cb, 8 * SB_KS), v1 = trfrag(vread + 16 * SB_KS + 64 * cb, 8 * SB_KS);
            oT[cb] = MFMA32(v0, wf0, oT[cb]); oT[cb] = MFMA32(v1, wf1, oT[cb]); }
        asm volatile("s_waitcnt lgkmcnt(0)" ::: "memory");
        if (__ballot(R <= 150.1f) == 0ull) break;
    }
    const size_t mrow = (rowbase + 32 * qt + n) * HW;
#pragma unroll
    for (int cb = 0; cb < 4; ++cb)
#pragma unroll
        for (int g = 0; g < 4; ++g) { const int dh0 = hd * 128 + 32 * cb + 8 * g + 4 * hh;
            const v2u mb = *(const v2u*)(H + mrow + C_MB + dh0);
            const float g0 = sigmoidf_(__uint_as_float(mb.x << 16)), g1 = sigmoidf_(__uint_as_float(mb.x & 0xffff0000u)), g2 = sigmoidf_(__uint_as_float(mb.y << 16)), g3 = sigmoidf_(__uint_as_float(mb.y & 0xffff0000u));
            v2u o; o.x = cvtpk(oT[cb][4 * g] * g0, oT[cb][4 * g + 1] * g1); o.y = cvtpk(oT[cb][4 * g + 2] * g2, oT[cb][4 * g + 3] * g3);
            *(v2u*)(H + mrow + C_SQ + dh0) = o; }
}
constexpr int GL_QS = 272, GL_VS = 528;
constexpr int GL_QE = 0, GL_KE = 64 * GL_QS, GL_KD = 2 * 64 * GL_QS, GL_VV = 3 * 64 * GL_QS, GL_GA = GL_VV + 64 * GL_VS, GL_SEG = GL_GA + 4096, GL_EB = GL_SEG + 2048, GL_SSQ = GL_EB + 512, GL_WUP = GL_SSQ + 2048, GL_END = GL_WUP + 8192;
static_assert(GL_END <= 131072, "GLA LDS map");
constexpr int GL_NSEG = 8, GL_SEGCH = (SEQ / 64) / GL_NSEG, GL_STATE = 8 * 4 * 16 * 64;
template <bool FULL>
__device__ __forceinline__ void gla_seg(bf16* H, const bf16* GA, const float* w_up, const float* b_alpha, const float* gng, float* Lst, float* Lsum, LAS unsigned char* lds, int unit, int tid) {
    const int b = unit >> 5, hg = (unit >> 3) & 3, sj = unit & 7;
    const int lane = tid & 63, wave = tid >> 6, n = lane & 31, hh = lane >> 5, i16 = lane & 15, tq = i16 >> 2, tp = i16 & 3, blk = (lane >> 4) & 1;
    const int d = tid & 127, seg = tid >> 7;
    LAS float* WUP = (LAS float*)(lds + GL_WUP);
#pragma unroll
    for (int r = 0; r < 4; ++r) WUP[(4 * seg + r) * 128 + d] = w_up[(4 * seg + r) * 512 + hg * 128 + d];
    f32x16 sacc[4];
#pragma unroll
    for (int db = 0; db < 4; ++db)
#pragma unroll
        for (int r = 0; r < 16; ++r) sacc[db][r] = 0.f;
    LAS float* GAc = (LAS float*)(lds + GL_GA); LAS float* SEG = (LAS float*)(lds + GL_SEG); LAS float* EB = (LAS float*)(lds + GL_EB); LAS float* SSQ = (LAS float*)(lds + GL_SSQ);
    const LAS unsigned char* vtr_base = lds + GL_VV + (4 * hh + tq) * GL_VS + (32 * wave + 16 * blk + 4 * tp) * 2;
    const LAS unsigned char* kdtr_base = lds + GL_KD + (4 * hh + tq) * GL_QS + (16 * blk + 4 * tp) * 2;
    float lsum = 0.f;
    if (FULL) {
        for (int jp = 0; jp < sj; ++jp) { const int up = unit - sj + jp;
            __syncthreads(); if (tid < 128) EB[tid] = ex2(Lsum[up * 128 + tid]); __syncthreads();
            const float* Lp = Lst + (size_t)up * GL_STATE + (size_t)wave * 4 * 16 * 64 + lane;
#pragma unroll
            for (int db = 0; db < 4; ++db)
#pragma unroll
                for (int g = 0; g < 4; ++g) { const f32x4 e4 = *(const LAS f32x4*)(EB + 32 * db + 8 * g + 4 * hh);
#pragma unroll
                    for (int j = 0; j < 4; ++j) sacc[db][4 * g + j] = sacc[db][4 * g + j] * e4[j] + Lp[(db * 16 + 4 * g + j) * 64]; } }
        __syncthreads();
    }
    for (int c = sj * GL_SEGCH; c < (sj + 1) * GL_SEGCH; ++c) {
        const size_t m0 = (size_t)b * SEQ + 64 * c;
        unsigned short qraw[16], kraw[16];
#pragma unroll
        for (int ii = 0; ii < 16; ++ii) { const bf16* rp = H + (m0 + 16 * seg + ii) * HW + hg * 128 + d; qraw[ii] = FULL ? rp[C_GQ] : (unsigned short)0; kraw[ii] = rp[C_GK]; }
#pragma unroll
        for (int e = tid; e < 1024; e += NTHR) GAc[e] = bf2f(GA[m0 * 16 + e]);
#pragma unroll
        for (int i = 0; i < 4; ++i) { const int id = tid + NTHR * i, row = id >> 5, ch = id & 31;
            *(LAS v4u*)(lds + GL_VV + row * GL_VS + ch * 16) = *(const v4u*)(H + (m0 + row) * HW + C_GV + hg * 256 + ch * 8); }
        __syncthreads();
        float bb[16]; float run = 0.f; float wup[16]; const float bal = b_alpha[hg * 128 + d];
#pragma unroll
        for (int r = 0; r < 16; ++r) wup[r] = WUP[r * 128 + d];
#pragma unroll
        for (int ii = 0; ii < 16; ++ii) { const LAS f32x4* g4 = (const LAS f32x4*)(GAc + (16 * seg + ii) * 16); float z = bal;
#pragma unroll
            for (int r4 = 0; r4 < 4; ++r4) { const f32x4 gv = g4[r4]; z += gv.x * wup[4 * r4] + gv.y * wup[4 * r4 + 1] + gv.z * wup[4 * r4 + 2] + gv.w * wup[4 * r4 + 3]; }
            run += -softplus2(-z * LOG2E) * (1.0f / 16.0f); bb[ii] = run; }
        SEG[seg * 128 + d] = run;
        __syncthreads();
        { const float t0 = SEG[d], t1 = SEG[128 + d], t2 = SEG[256 + d], t3 = SEG[384 + d];
          const float off = (seg > 0 ? t0 : 0.f) + (seg > 1 ? t1 : 0.f) + (seg > 2 ? t2 : 0.f); const float blast = ((t0 + t1) + t2) + t3;
          if (seg == 0) { EB[d] = ex2(blast); lsum += blast; }
#pragma unroll
          for (int ii = 0; ii < 16; ++ii) { const int i = 16 * seg + ii; const float bi = bb[ii] + off; const float qv = bf2f(qraw[ii]), kv = bf2f(kraw[ii]);
              if (FULL) { *(LAS unsigned short*)(lds + GL_QE + i * GL_QS + d * 2) = (unsigned short)(cvtpk(qv * QK_SCALE * ex2(bi), 0.f) & 0xffffu);
                          *(LAS unsigned short*)(lds + GL_KE + i * GL_QS + d * 2) = (unsigned short)(cvtpk(kv * ex2(-bi), 0.f) & 0xffffu); }
              *(LAS unsigned short*)(lds + GL_KD + i * GL_QS + d * 2) = (unsigned short)(cvtpk(kv * ex2(blast - bi), 0.f) & 0xffffu); } }
        __syncthreads();
        f32x16 oT[2];
#pragma unroll
        for (int tb = 0; tb < 2; ++tb)
#pragma unroll
            for (int r = 0; r < 16; ++r) oT[tb][r] = 0.f;
        if (FULL) {
#pragma unroll
        for (int db = 0; db < 4; ++db)
#pragma unroll
            for (int s = 0; s < 2; ++s) { const bf16x8 sf = PACK_STEP(sacc[db], s);
#pragma unroll
                for (int tb = 0; tb < 2; ++tb) { const LAS unsigned char* qb = lds + GL_QE + (32 * tb + n) * GL_QS + (32 * db + 16 * s + 4 * hh) * 2;
                    const s16x4 lo = *(const LAS s16x4*)qb, hi = *(const LAS s16x4*)(qb + 16); const bf16x8 bq = __builtin_shufflevector(lo, hi, 0, 1, 2, 3, 4, 5, 6, 7);
                    oT[tb] = MFMA32(sf, bq, oT[tb]); } }
        }
        bf16x8 vf[2][2];
#pragma unroll
        for (int sb = 0; sb < 2; ++sb)
#pragma unroll
            for (int s2 = 0; s2 < 2; ++s2) vf[sb][s2] = trfrag(vtr_base + (32 * sb + 16 * s2) * GL_VS, 8 * GL_VS);
        if (FULL) {
#pragma unroll
        for (int blk3 = 0; blk3 < 3; ++blk3) { const int sb = blk3 >> 1, tb = (blk3 + 1) >> 1;
            f32x16 pt;
#pragma unroll
            for (int r = 0; r < 16; ++r) pt[r] = 0.f;
#pragma unroll
            for (int ks = 0; ks < 8; ++ks) { const bf16x8 ka = *(const LAS bf16x8*)(lds + GL_KE + (32 * sb + n) * GL_QS + (16 * ks + 8 * hh) * 2);
                const bf16x8 qb = *(const LAS bf16x8*)(lds + GL_QE + (32 * tb + n) * GL_QS + (16 * ks + 8 * hh) * 2); pt = MFMA32(ka, qb, pt); }
            if (sb == tb) {
#pragma unroll
                for (int r = 0; r < 16; ++r) pt[r] = (crow(r, hh) <= n) ? pt[r] : 0.f; }
            const bf16x8 p0 = PACK_STEP(pt, 0), p1 = PACK_STEP(pt, 1);
            oT[tb] = MFMA32(vf[sb][0], p0, oT[tb]); oT[tb] = MFMA32(vf[sb][1], p1, oT[tb]); }
        }
#pragma unroll
        for (int db = 0; db < 4; ++db) {
#pragma unroll
            for (int g = 0; g < 4; ++g) { const f32x4 e4 = *(const LAS f32x4*)(EB + 32 * db + 8 * g + 4 * hh);
                sacc[db][4 * g] *= e4.x; sacc[db][4 * g + 1] *= e4.y; sacc[db][4 * g + 2] *= e4.z; sacc[db][4 * g + 3] *= e4.w; }
#pragma unroll
            for (int sb = 0; sb < 2; ++sb)
#pragma unroll
                for (int s2 = 0; s2 < 2; ++s2) { const bf16x8 kdf = trfrag(kdtr_base + (32 * sb + 16 * s2) * GL_QS + 64 * db, 8 * GL_QS); sacc[db] = MFMA32(kdf, vf[sb][s2], sacc[db]); } }
        if (!FULL) { __syncthreads(); continue; }
#pragma unroll
        for (int tb = 0; tb < 2; ++tb) { float ss = 0.f;
#pragma unroll
            for (int r = 0; r < 16; ++r) ss += oT[tb][r] * oT[tb][r];
            ss += __shfl_xor(ss, 32); if (hh == 0) SSQ[wave * 64 + 32 * tb + n] = ss; }
        __syncthreads();
#pragma unroll
        for (int tb = 0; tb < 2; ++tb) { const int t = 32 * tb + n; float tot = 0.f;
#pragma unroll
            for (int w8 = 0; w8 < 8; ++w8) tot += SSQ[w8 * 64 + t];
            const float rstd = 1.0f / sqrtf(tot * (1.0f / 256.0f) + LN_EPS); bf16* rowp = H + (m0 + t) * HW;
#pragma unroll
            for (int g = 0; g < 4; ++g) { const int col = hg * 256 + 32 * wave + 8 * g + 4 * hh;
                const v2u gg = *(const v2u*)(rowp + C_GG + col), ma = *(const v2u*)(rowp + C_MA + col), os = *(const v2u*)(rowp + C_SQ + col); const f32x4 gn = *(const f32x4*)(gng + col);
                const float x0 = __uint_as_float(gg.x << 16), x1 = __uint_as_float(gg.x & 0xffff0000u), x2 = __uint_as_float(gg.y << 16), x3 = __uint_as_float(gg.y & 0xffff0000u);
                const float a0 = __uint_as_float(ma.x << 16), a1 = __uint_as_float(ma.x & 0xffff0000u), a2 = __uint_as_float(ma.y << 16), a3 = __uint_as_float(ma.y & 0xffff0000u);
                const float o0 = oT[tb][4 * g] * rstd * gn.x * (x0 * sigmoidf_(x0)) * sigmoidf_(a0), o1 = oT[tb][4 * g + 1] * rstd * gn.y * (x1 * sigmoidf_(x1)) * sigmoidf_(a1);
                const float o2 = oT[tb][4 * g + 2] * rstd * gn.z * (x2 * sigmoidf_(x2)) * sigmoidf_(a2), o3 = oT[tb][4 * g + 3] * rstd * gn.w * (x3 * sigmoidf_(x3)) * sigmoidf_(a3);
                v2u o; o.x = cvtpk(o0 + __uint_as_float(os.x << 16), o1 + __uint_as_float(os.x & 0xffff0000u)); o.y = cvtpk(o2 + __uint_as_float(os.y << 16), o3 + __uint_as_float(os.y & 0xffff0000u)); *(v2u*)(rowp + C_GG + col) = o; } }
    }
    if (!FULL) {
        float* Lp = Lst + (size_t)unit * GL_STATE + (size_t)wave * 4 * 16 * 64 + lane;
#pragma unroll
        for (int db = 0; db < 4; ++db)
#pragma unroll
            for (int r = 0; r < 16; ++r) Lp[(db * 16 + r) * 64] = sacc[db][r];
        if (tid < 128) Lsum[unit * 128 + tid] = lsum;
    }
}
#define RLX_AGENT __ATOMIC_RELAXED, __HIP_MEMORY_SCOPE_AGENT
#define XB_TMO      128
#define XB_XCNT(j)  (256  + 64 * (j))
#define XB_XSUB(j)  (1280 + 64 * (j))
#define XB_XGEN(j)  (2304 + 64 * (j))
#define XB_TOP      3328
#define XB_TOPGEN   3392
#define XCD_BAR_WORDS 3456
#define XB_SPIN_CAP (1u << 18)

__device__ __forceinline__ unsigned xb_ld(unsigned* p)              { return __hip_atomic_load(p, __ATOMIC_RELAXED, __HIP_MEMORY_SCOPE_AGENT); }
__device__ __forceinline__ unsigned xb_add(unsigned* p, unsigned v) { return __hip_atomic_fetch_add(p, v, __ATOMIC_RELAXED, __HIP_MEMORY_SCOPE_AGENT); }
__device__ __forceinline__ unsigned xb_xcc_id() { return (unsigned)__builtin_amdgcn_s_getreg((3 << 11) | 20) & 0xFu; }
#define XB_SPIN(cond, bar) do { unsigned _sp = 0; while (cond) { __builtin_amdgcn_s_sleep(1); \
    if ((++_sp & 255u) == 0u) { if (xb_ld(&(bar)[XB_TMO])) break; if (_sp > XB_SPIN_CAP) { atomicAdd(&(bar)[XB_TMO], 1u); break; } } } } while (0)

struct XcdBarrier {
    unsigned* bar; unsigned x;
    volatile LAS unsigned* st;
};

__device__ __forceinline__ XcdBarrier xcd_barrier_post(unsigned* bar, volatile LAS unsigned* st) {
    XcdBarrier b; b.bar = bar; b.x = xb_xcc_id(); b.st = st;
    if (threadIdx.x == 0) (void)xb_add(&bar[XB_XCNT(b.x)], 1u);
    return b;
}
__device__ __forceinline__ void xcd_barrier_complete(unsigned* bar, unsigned x, unsigned& nloc, unsigned& nx) {
    const unsigned G = gridDim.x * gridDim.y * gridDim.z;
    unsigned sum, cnt, mine, sp = 0u;
    for (;;) {
        sum = 0u; cnt = 0u; mine = 0u;
#pragma unroll
        for (unsigned j = 0; j < 16; ++j) { const unsigned c = xb_ld(&bar[XB_XCNT(j)]); sum += c; cnt += (c > 0u) ? 1u : 0u; mine = (j == x) ? c : mine; }
        if (sum == G) break;
        __builtin_amdgcn_s_sleep(1);
        if ((++sp & 255u) == 0u) { if (xb_ld(&bar[XB_TMO])) break; if (sp > XB_SPIN_CAP) { atomicAdd(&bar[XB_TMO], 1u); break; } }
    }
    nloc = mine > 0u ? mine : 1u; nx = cnt > 0u ? cnt : 1u;
}

__device__ __forceinline__ void xcd_barrier(const XcdBarrier& b) {
    asm volatile("s_waitcnt vmcnt(0)" ::: "memory");
    __syncthreads();
    if (threadIdx.x == 0) {
        unsigned* bar = b.bar;
        __builtin_amdgcn_s_waitcnt(0);
        unsigned nloc = b.st[0], nx = b.st[1];
        if (nloc == 0u) { xcd_barrier_complete(bar, b.x, nloc, nx); b.st[0] = nloc; b.st[1] = nx; }
        const unsigned old = xb_add(&bar[XB_XSUB(b.x)], 1u);
        const unsigned gen = old / nloc;
        if (old + 1u == (gen + 1u) * nloc) {
            __builtin_amdgcn_fence(__ATOMIC_RELEASE, "agent");
            asm volatile("s_waitcnt vmcnt(0)" ::: "memory");
            const unsigned og = xb_add(&bar[XB_TOP], 1u);
            const unsigned tg = og / nx;
            if (og + 1u == (tg + 1u) * nx) xb_add(&bar[XB_TOPGEN], 1u);
            else XB_SPIN(xb_ld(&bar[XB_TOPGEN]) == tg, bar);
            __builtin_amdgcn_fence(__ATOMIC_ACQUIRE, "agent");
            xb_add(&bar[XB_XGEN(b.x)], 1u);
            asm volatile("s_waitcnt vmcnt(0)" ::: "memory");
        } else {
            XB_SPIN(xb_ld(&bar[XB_XGEN(b.x)]) == gen, bar);
            __builtin_amdgcn_fence(__ATOMIC_ACQUIRE, "agent");
            asm volatile("s_waitcnt vmcnt(0)" ::: "memory");
        }
    }
    __syncthreads();
}

constexpr size_t DO_BAR = 107 * MiB;
constexpr int MISC_OFF = LDS_BYTES - 64;
__global__ void __launch_bounds__(NTHR, 2) fwd_megakernel(Args args) {
    extern __shared__ __attribute__((aligned(16))) unsigned char lds_raw[];
    cg::grid_group grid = cg::this_grid();
    LAS unsigned char* lds = (LAS unsigned char*)lds_raw;
    const int tid = threadIdx.x, lane = tid & 63, wave = __builtin_amdgcn_readfirstlane(tid >> 6);
    const int G = gridDim.x, bx = blockIdx.x;
    const float* x = args.in[0]; const float* cvec = args.in[1]; const float* w_ada = args.in[2]; const float* b_ada = args.in[3]; const float* w_in = args.in[4];
    const float* w_up = args.in[5]; const float* b_alpha = args.in[6]; const float* gng = args.in[7]; const float* w_out = args.in[8];
    const float* ln1_g = args.in[9]; const float* ln1_b = args.in[10]; const float* w_ffin = args.in[11]; const float* w_ffout = args.in[12]; const float* ln2_g = args.in[13]; const float* ln2_b = args.in[14];
    unsigned char* dsc = (unsigned char*)args.out;
    bf16* H = (bf16*)args.ws; float* Hf = (float*)args.ws;
    bf16* U1 = (bf16*)(dsc + DO_U1); bf16* Wt_in = (bf16*)(dsc + DO_WIN); bf16* Wt_out = (bf16*)(dsc + DO_WOUT); bf16* Wt_ffin = (bf16*)(dsc + DO_WFFIN); bf16* Wt_ffout = (bf16*)(dsc + DO_WFFOUT);
    bf16* GA = (bf16*)(dsc + DO_GA); float* Lst = (float*)(dsc + DO_U1); float* Lsum = (float*)(dsc + DO_U1 + 32 * MiB); float* modp = (float*)(dsc + DO_MODP); float* modf = (float*)(dsc + DO_MODF);

    volatile LAS unsigned* MISC = (volatile LAS unsigned*)(lds + MISC_OFF);
    if (tid < 16) MISC[tid] = 0u;
    __syncthreads();
    const XcdBarrier xbar = xcd_barrier_post((unsigned*)(dsc + DO_BAR), MISC);
    {
        LAS float* scr = (LAS float*)(lds + wave * 16384);
        const int gw = bx * NWAVES + wave, NGW = G * NWAVES;
        constexpr int I_ADA = 96 * 16, I_IN = (NIN / 32) * (D / 64), I_OUT = (D / 32) * (D / 64), I_FI = (2 * FF / 32) * (D / 64), I_FO = (D / 32) * (FF / 64);
        constexpr int NITEMS = I_ADA + I_IN + I_OUT + I_FI + I_FO;
        for (int it = gw; it < NITEMS; it += NGW) {
            int r = it;
            if (r < I_ADA) {
                const int cgp = r % 96, ks = r / 96, col = 64 * cgp + lane, k0 = 64 * ks;
                float sc[8], acc[8];
#pragma unroll
                for (int b = 0; b < 8; ++b) { const float cv = cvec[b * D + k0 + lane]; sc[b] = cv * sigmoidf_(cv); acc[b] = 0.f; }
#pragma unroll 8
                for (int kk = 0; kk < 64; ++kk) { const float w = w_ada[(size_t)(k0 + kk) * NMOD + col];
#pragma unroll
                    for (int b = 0; b < 8; ++b) acc[b] += __shfl(sc[b], kk) * w; }
#pragma unroll
                for (int b = 0; b < 8; ++b) modp[(size_t)(ks * 8 + b) * NMOD + col] = acc[b];
                continue;
            }
            r -= I_ADA;
            if (r < I_IN) { transpose_item(w_in, 8208, Wt_in, D, 32 * (r % (NIN / 32)), 64 * (r / (NIN / 32)), 0, false, scr, lane); continue; } r -= I_IN;
            if (r < I_OUT) { transpose_item(w_out, D, Wt_out, D, 32 * (r % (D / 32)), 64 * (r / (D / 32)), 2, false, scr, lane); continue; } r -= I_OUT;
            if (r < I_FI) { transpose_item(w_ffin, 2 * FF, Wt_ffin, D, 32 * (r % (2 * FF / 32)), 64 * (r / (2 * FF / 32)), 1, false, scr, lane); continue; } r -= I_FI;
            transpose_item(w_ffout, D, Wt_ffout, FF, 32 * (r % (D / 32)), 64 * (r / (D / 32)), 2, false, scr, lane);
        }
    }
    grid.sync();

    {
        for (int idx = bx * NTHR + tid; idx < BATCH * NMOD; idx += G * NTHR) { const int b = idx / NMOD, j = idx % NMOD; float s = b_ada[j];
#pragma unroll
            for (int ks = 0; ks < 16; ++ks) s += modp[(size_t)(ks * 8 + b) * NMOD + j];
            modf[idx] = s; }
        LAS float* ssh = (LAS float*)lds; LAS float* ssc = ssh + D;
        for (int rg = bx; rg < M / 128; rg += G) {
            const int b = rg / (SEQ / 128);
            __syncthreads();
            for (int j = tid; j < 2 * D; j += NTHR) { float s = b_ada[j];
#pragma unroll
                for (int ks = 0; ks < 16; ++ks) s += modp[(size_t)(ks * 8 + b) * NMOD + j];
                ssh[j] = s; }
            __syncthreads();
            for (int i = 0; i < 16; ++i) { const size_t row = (size_t)rg * 128 + wave * 16 + i;
                const f32x4* xr = (const f32x4*)(x + row * D) + lane; f32x4 v[4];
#pragma unroll
                for (int j = 0; j < 4; ++j) v[j] = xr[64 * j];
                float rstd; row_stats(v, rstd);
                unsigned long long* o8 = (unsigned long long*)(U1 + row * D) + lane;
#pragma unroll
                for (int j = 0; j < 4; ++j) { const int c0 = 4 * lane + 256 * j; const f32x4 sc = *(const LAS f32x4*)(ssc + c0), sh = *(const LAS f32x4*)(ssh + c0);
                    const f32x4 o = v[j] * rstd * (sc + 1.0f) + sh; o8[64 * j] = (unsigned long long)cvtpk(o.x, o.y) | ((unsigned long long)cvtpk(o.z, o.w) << 32); } }
        }
    }
    xcd_barrier(xbar);

    { pg8::Gemm g{U1, Wt_in, M, NIN, D, D}; pg8::StaticOrder S; S.init(M, NIN, G, bx); pg8::EpiH E{H, GA};
      pg8::gemm_phase<pg8::EpiH, pg8::StaticOrder, PG8_ALIGN, PG8_SP2>(lds, g, S, E); }
    xcd_barrier(xbar);

    {
        for (int unit = bx; unit < BATCH * 4 * GL_NSEG; unit += G) { if ((unit & 7) != 7) { int t_ = tid; asm volatile("" : "+v"(t_)); gla_seg<false>(H, GA, w_up, b_alpha, gng, Lst, Lsum, lds, unit, t_); } __syncthreads(); }
        LAS unsigned char* wl = lds + wave * (64 * SB_KS);
        for (int u = bx * NWAVES + wave; u < BATCH * 8 * (SEQ / 32); u += G * NWAVES) { const int qt = u & 127, bh = u >> 7; int l_ = lane; asm volatile("" : "+v"(l_)); sb_unit(H, wl, bh >> 3, bh & 7, qt, l_); }
    }
    xcd_barrier(xbar);
    for (int unit = bx; unit < BATCH * 4 * GL_NSEG; unit += G) { __syncthreads(); int t_ = tid; asm volatile("" : "+v"(t_)); gla_seg<true>(H, GA, w_up, b_alpha, gng, Lst, Lsum, lds, unit, t_); }
    xcd_barrier(xbar);

    { pg8::Gemm g{H + C_GG, Wt_out, M, D, D, HW}; pg8::StaticOrder S; S.init(M, D, G, bx); pg8::EpiRes E{x, D, Hf + F_R, HROWF, modf + 2 * D, ALPHA};
      pg8::gemm_phase<pg8::EpiRes, pg8::StaticOrder, PG8_ALIGN, PG8_SP2>(lds, g, S, E); }
    xcd_barrier(xbar);

    {
        LAS float* sg = (LAS float*)lds; LAS float* sb_ = sg + D; LAS float* ssh = sb_ + D; LAS float* ssc = ssh + D;
        for (int rg = bx; rg < M / 128; rg += G) {
            const int b = rg / (SEQ / 128);
            __syncthreads();
            for (int j = tid; j < D; j += NTHR) { sg[j] = ln1_g[j]; sb_[j] = ln1_b[j]; ssh[j] = modf[(size_t)b * NMOD + 3 * D + j]; ssc[j] = modf[(size_t)b * NMOD + 4 * D + j]; }
            __syncthreads();
            for (int i = 0; i < 16; ++i) { const size_t row = (size_t)rg * 128 + wave * 16 + i;
                const f32x4* rr = (const f32x4*)(Hf + row * HROWF + F_R) + lane; f32x4 v[4];
#pragma unroll
                for (int j = 0; j < 4; ++j) v[j] = rr[64 * j];
                float rstd; row_stats(v, rstd);
                f32x4* x1o = (f32x4*)(Hf + row * HROWF + F_X1) + lane;
#pragma unroll
                for (int j = 0; j < 4; ++j) { const int c0 = 4 * lane + 256 * j; v[j] = v[j] * rstd * *(const LAS f32x4*)(sg + c0) + *(const LAS f32x4*)(sb_ + c0); x1o[64 * j] = v[j]; }
                row_stats(v, rstd);
                unsigned long long* o8 = (unsigned long long*)(H + row * HW + C_U2) + lane;
#pragma unroll
                for (int j = 0; j < 4; ++j) { const int c0 = 4 * lane + 256 * j; const f32x4 o = v[j] * rstd * (*(const LAS f32x4*)(ssc + c0) + 1.0f) + *(const LAS f32x4*)(ssh + c0);
                    o8[64 * j] = (unsigned long long)cvtpk(o.x, o.y) | ((unsigned long long)cvtpk(o.z, o.w) << 32); } }
        }
    }
    xcd_barrier(xbar);

    { pg8::Gemm g{H + C_U2, Wt_ffin, M, 2 * FF, D, HW}; pg8::StaticOrder S; S.init(M, 2 * FF, G, bx); pg8::EpiSwiglu E{H + C_ACT, HW};
      pg8::gemm_phase<pg8::EpiSwiglu, pg8::StaticOrder, PG8_ALIGN, PG8_SP2>(lds, g, S, E); }
    xcd_barrier(xbar);

    { pg8::Gemm g{H + C_ACT, Wt_ffout, M, D, FF, HW}; pg8::StaticOrder S; S.init(M, D, G, bx); pg8::EpiRes E{Hf + F_X1, HROWF, Hf + F_R, HROWF, modf + 5 * D, ALPHA};
      pg8::gemm_phase<pg8::EpiRes, pg8::StaticOrder, PG8_ALIGN, PG8_SP2>(lds, g, S, E); }
    grid.sync();

    {
        for (size_t row = (size_t)bx * NWAVES + wave; row < (size_t)M; row += (size_t)G * NWAVES) {
            const f32x4* rr = (const f32x4*)(Hf + row * HROWF + F_R) + lane; f32x4 v[4];
#pragma unroll
            for (int j = 0; j < 4; ++j) v[j] = rr[64 * j];
            float rstd; row_stats(v, rstd);
            f32x4* oo = (f32x4*)(args.out + row * D) + lane;
#pragma unroll
            for (int j = 0; j < 4; ++j) { const int c0 = 4 * lane + 256 * j; oo[64 * j] = v[j] * rstd * *(const f32x4*)(ln2_g + c0) + *(const f32x4*)(ln2_b + c0); }
        }
    }
}

extern "C" void kernel_launch(void* const* d_in, const int* in_sizes, int n_in, void* d_out, int out_size, void* d_ws, size_t ws_size, hipStream_t stream) {
    static int grid = 0;
    if (grid == 0) {
        if (n_in != 15 || out_size != M * D || ws_size < (size_t)M * HW * 2) { fprintf(stderr, "kernel_launch: unexpected problem shape (n_in %d, out %d, ws %zu)\n", n_in, out_size, ws_size); grid = -1; return; }
        int dev = 0, cus = 0, per_cu = 0;
        if (hipGetDevice(&dev) != hipSuccess || hipDeviceGetAttribute(&cus, hipDeviceAttributeMultiprocessorCount, dev) != hipSuccess) { grid = -1; return; }
        if (hipFuncSetAttribute((const void*)fwd_megakernel, hipFuncAttributeMaxDynamicSharedMemorySize, LDS_BYTES) != hipSuccess) { fprintf(stderr, "kernel_launch: hipFuncSetAttribute failed\n"); grid = -1; return; }
        if (hipOccupancyMaxActiveBlocksPerMultiprocessor(&per_cu, (const void*)fwd_megakernel, NTHR, LDS_BYTES) != hipSuccess || per_cu < 1) { fprintf(stderr, "kernel_launch: occupancy query gave %d\n", per_cu); per_cu = 1; }
        (void)hipGetLastError();
        grid = cus * per_cu;
    }
    if (grid < 0) return;
    if (hipMemsetAsync((char*)d_out + DO_BAR, 0, 16384, stream) != hipSuccess) { fprintf(stderr, "kernel_launch: memset failed\n"); return; }
    Args a{};
    for (int i = 0; i < 15; ++i) a.in[i] = (const float*)d_in[i];
    a.out = (float*)d_out; a.ws = (unsigned char*)d_ws;
    void* kargs[] = {&a};
    const hipError_t e = hipLaunchCooperativeKernel((const void*)fwd_megakernel, dim3(grid), dim3(NTHR), kargs, LDS_BYTES, stream);
    if (e != hipSuccess) fprintf(stderr, "kernel_launch: cooperative launch failed: %s (grid %d)\n", hipGetErrorString(e), grid);
}
```

```cpp
#include <hip/hip_runtime.h>
#include <hip/hip_cooperative_groups.h>
#include <cstdio>
#include <cstdint>
namespace cg = cooperative_groups;
namespace pg8 {
#define PG8_LAS __attribute__((address_space(3)))
typedef unsigned short bf16_t;
typedef short bf16x8 __attribute__((ext_vector_type(8)));
typedef float f32x4 __attribute__((ext_vector_type(4)));
typedef unsigned u32x4 __attribute__((ext_vector_type(4)));
constexpr int BM = 256, BK = 64, HALF = 128, HTB = HALF * BK * 2  , STAGE_BYTES = 8 * HTB, NXCD = 8, WGM = 8;

__host__ __device__ __forceinline__ int lds_byte(int r, int c) { const int st = (r >> 4) * 2 + (c >> 5), rr = r & 15, cc = c & 31, ob = rr * 64 + cc * 2; return st * 1024 + (ob ^ (((ob >> 9) & 1) << 5)); }
__host__ __device__ __forceinline__ void stage_rc(int b, int& R, int& C) { const int st = b / 1024, sb = b % 1024, swz = sb ^ (((sb >> 9) & 1) << 5); R = (st >> 1) * 16 + swz / 64; C = (st & 1) * 32 + (swz % 64) / 2; }
__host__ __device__ __forceinline__ int perm32(int rho) { const int n = rho >> 4, i = rho & 15; return 8 * (i >> 2) + 4 * n + (i & 3); }

struct Unit { int pm, pn; };
struct Gemm { const bf16_t* A; const bf16_t* Bt; int M, N, K, lda; };

struct StaticOrder {
    int nM, nN, nwg, G, c;
    __host__ __device__ void init(int M, int N, int G_, int c_) { nM = M / BM; nN = N / BM; nwg = nM * nN; G = G_; c = c_; }
    __host__ __device__ bool next(int i, Unit& u) const {
        const long L = (long)i * G + c; if (L >= nwg) return false;
        int wgid = (int)L; { const int q = nwg / NXCD, r = nwg % NXCD, xcd = wgid % NXCD, off = wgid / NXCD; wgid = (xcd < r ? xcd * (q + 1) : r * (q + 1) + (xcd - r) * q) + off; }
        const int nig = WGM * nN, gid = wgid / nig, fm = gid * WGM, gsz = (nM - fm) < WGM ? (nM - fm) : WGM;
        u.pm = fm + ((wgid % nig) % gsz); u.pn = (wgid % nig) / gsz; return true;
    }
    __device__ __forceinline__ void a_ready(const Unit&) const {}
    __device__ __forceinline__ void done(const Unit&) const {}
};

__device__ __forceinline__ unsigned cvt_pk_bf16(float lo, float hi) { unsigned r; asm volatile("v_cvt_pk_bf16_f32 %0, %1, %2" : "=v"(r) : "v"(lo), "v"(hi)); return r; }
typedef __bf16 bf16x2_t __attribute__((ext_vector_type(2)));
typedef float f32x2_t __attribute__((ext_vector_type(2)));
typedef unsigned u32x2 __attribute__((ext_vector_type(2)));
__device__ __forceinline__ unsigned cvtpk(float lo, float hi) { f32x2_t v = {lo, hi}; bf16x2_t b = __builtin_convertvector(v, bf16x2_t); return __builtin_bit_cast(unsigned, b); }

struct EpiH {
    static constexpr bool PERM = true, AFTER_DRAIN = false;
    bf16_t* H; bf16_t* GA;
    __device__ __forceinline__ void operator()(const f32x4 (&acc)[2][2][4][2], const Unit& u, int wr, int wc, int fr, int fq) const {
        const int row0 = u.pm * BM + wr * 64 + fr;
        if (u.pn < 32) {
            const int col0 = u.pn * BM + wc * 32 + 8 * fq;
#pragma unroll
            for (int ai = 0; ai < 2; ++ai)
#pragma unroll
                for (int m = 0; m < 4; ++m) { bf16_t* rowp = H + (size_t)(row0 + ai * HALF + m * 16) * 8192 + col0;
#pragma unroll
                    for (int bj = 0; bj < 2; ++bj) { const f32x4 v0 = acc[ai][bj][m][0], v1 = acc[ai][bj][m][1];
                        u32x4 w; w.x = cvtpk(v0[0], v0[1]); w.y = cvtpk(v0[2], v0[3]); w.z = cvtpk(v1[0], v1[1]); w.w = cvtpk(v1[2], v1[3]);
                        *(u32x4*)(rowp + bj * HALF) = w; } }
        } else if (wc == 0 && fq < 2) {
#pragma unroll
            for (int ai = 0; ai < 2; ++ai)
#pragma unroll
                for (int m = 0; m < 4; ++m) { const f32x4 v0 = acc[ai][0][m][0], v1 = acc[ai][0][m][1];
                    u32x4 w; w.x = cvtpk(v0[0], v0[1]); w.y = cvtpk(v0[2], v0[3]); w.z = cvtpk(v1[0], v1[1]); w.w = cvtpk(v1[2], v1[3]);
                    *(u32x4*)(GA + (size_t)(row0 + ai * HALF + m * 16) * 16 + 8 * fq) = w; }
        }
    }
};
template <bool XBF> struct EpiRes {
    static constexpr bool PERM = true, AFTER_DRAIN = false;
    const void* X; int ldx; bf16_t* O; int ldo; const float* gate; float alpha;
    __device__ __forceinline__ void operator()(const f32x4 (&acc)[2][2][4][2], const Unit& u, int wr, int wc, int fr, int fq) const {
        const int b = u.pm >> 4; const int col0 = u.pn * BM + wc * 32 + 8 * fq;
#pragma unroll
        for (int bj = 0; bj < 2; ++bj) { const int c = col0 + bj * HALF;
            const f32x4 g0 = *(const f32x4*)(gate + (size_t)b * 6144 + c) + 1.0f, g1 = *(const f32x4*)(gate + (size_t)b * 6144 + c + 4) + 1.0f;
#pragma unroll
            for (int ai = 0; ai < 2; ++ai)
#pragma unroll
                for (int m = 0; m < 4; ++m) { const size_t r = (size_t)(u.pm * BM + ai * HALF + wr * 64 + m * 16 + fr); f32x4 x0, x1;
                    if (XBF) { const u32x4 xv = *(const u32x4*)((const bf16_t*)X + r * ldx + c);
                        x0 = (f32x4){__uint_as_float(xv.x << 16), __uint_as_float(xv.x & 0xffff0000u), __uint_as_float(xv.y << 16), __uint_as_float(xv.y & 0xffff0000u)};
                        x1 = (f32x4){__uint_as_float(xv.z << 16), __uint_as_float(xv.z & 0xffff0000u), __uint_as_float(xv.w << 16), __uint_as_float(xv.w & 0xffff0000u)}; }
                    else { const float* xp = (const float*)X + r * ldx + c; x0 = *(const f32x4*)xp; x1 = *(const f32x4*)(xp + 4); }
                    const f32x4 o0 = x0 * alpha + g0 * acc[ai][bj][m][0], o1 = x1 * alpha + g1 * acc[ai][bj][m][1];
                    u32x4 w; w.x = cvtpk(o0[0], o0[1]); w.y = cvtpk(o0[2], o0[3]); w.z = cvtpk(o1[0], o1[1]); w.w = cvtpk(o1[2], o1[3]);
                    *(u32x4*)(O + r * ldo + c) = w; } }
    }
};
struct EpiSwiglu {
    static constexpr bool PERM = true, AFTER_DRAIN = false;
    bf16_t* O; int ldo;
    __device__ __forceinline__ void operator()(const f32x4 (&acc)[2][2][4][2], const Unit& u, int wr, int wc, int fr, int fq) const {
        const int row0 = u.pm * BM + wr * 64 + fr; const int col0 = u.pn * HALF + wc * 32 + 8 * fq;
#pragma unroll
        for (int ai = 0; ai < 2; ++ai)
#pragma unroll
            for (int m = 0; m < 4; ++m) { float a[8];
#pragma unroll
                for (int n = 0; n < 2; ++n)
#pragma unroll
                    for (int j = 0; j < 4; ++j) { const float g = acc[ai][0][m][n][j], up = acc[ai][1][m][n][j]; a[4 * n + j] = g * __builtin_amdgcn_rcpf(1.0f + __builtin_amdgcn_exp2f(-g * 1.4426950408889634f)) * up; }
                u32x4 w; w.x = cvtpk(a[0], a[1]); w.y = cvtpk(a[2], a[3]); w.z = cvtpk(a[4], a[5]); w.w = cvtpk(a[6], a[7]);
                *(u32x4*)(O + (size_t)(row0 + ai * HALF + m * 16) * ldo + col0) = w; }
    }
};

template <class Epi, class Sched, bool ALIGN_EPI = false, bool SP2 = false>
__device__ __forceinline__ void gemm_phase(PG8_LAS unsigned char* lds, const Gemm g, const Sched& S, const Epi& E) {
    int tid_ = threadIdx.x; asm volatile("" : "+v"(tid_));
    const int tid = tid_, wid = __builtin_amdgcn_readfirstlane(tid >> 6), lane = tid & 63, wr = wid >> 2, wc = wid & 3, fr = lane & 15, fq = lane >> 4;
    const int K = g.K, nt = K / BK;
    unsigned voffA[2], voffB[2];
#pragma unroll
    for (int i = 0; i < 2; ++i) { int R, C; stage_rc(tid * 16 + i * 8192, R, C); const int Rb = Epi::PERM ? ((R & ~31) + perm32(R & 31)) : R;
        voffA[i] = (unsigned)(R * g.lda + C) * 2u; voffB[i] = (unsigned)(Rb * K + C) * 2u; }
    const size_t kstep = (size_t)(BK * 2);
    const size_t hstepA = (size_t)HALF * g.lda * 2, hstepB = (size_t)HALF * K * 2;
    const size_t tstepA = 2 * hstepA, tstepB = 2 * hstepB;
    const unsigned ldsw = (unsigned)wid * 1024u;
    const int aoff = lds_byte(wr * 64 + fr, fq * 8), boff = lds_byte(wc * 32 + fr, fq * 8);
#define PG8_SA(b, h) (((b) * 2 + (h)) * HTB)
#define PG8_SB(b, h) ((4 + (b) * 2 + (h)) * HTB)
#define PG8_STAGE(bufoff, gbase, voff) do { _Pragma("unroll") for (int _i = 0; _i < 2; ++_i) \
        __builtin_amdgcn_global_load_lds((const unsigned*)((const char*)(gbase) + (voff)[_i]), (PG8_LAS unsigned*)(lds + (bufoff) + ldsw + _i * 8192), 16, 0, 0); } while (0)
#define PG8_LDA(dst, b, h) do { _Pragma("unroll") for (int m = 0; m < 4; ++m) _Pragma("unroll") for (int k = 0; k < 2; ++k) dst[m][k] = *(const PG8_LAS bf16x8*)(lds + PG8_SA(b, h) + aoff + m * 2048 + k * 1024); } while (0)
#define PG8_LDB(dst, b, h) do { _Pragma("unroll") for (int n = 0; n < 2; ++n) _Pragma("unroll") for (int k = 0; k < 2; ++k) dst[n][k] = *(const PG8_LAS bf16x8*)(lds + PG8_SB(b, h) + boff + n * 2048 + k * 1024); } while (0)
#define PG8_MMA(ai, bj, At, Bt) do { __builtin_amdgcn_s_setprio(1); _Pragma("unroll") for (int m = 0; m < 4; ++m) _Pragma("unroll") for (int n = 0; n < 2; ++n) _Pragma("unroll") for (int k = 0; k < 2; ++k) \
        acc[ai][bj][m][n] = __builtin_amdgcn_mfma_f32_16x16x32_bf16(Bt[n][k], At[m][k], acc[ai][bj][m][n], 0, 0, 0); __builtin_amdgcn_s_setprio(0); } while (0)
#define PG8_WAIT_V(n) asm volatile("s_waitcnt vmcnt(" #n ")" ::: "memory")
#define PG8_WAIT_L(n) asm volatile("s_waitcnt lgkmcnt(" #n ")" ::: "memory")
#define PG8_BAR __builtin_amdgcn_s_barrier()
#define PG8_SCHED __builtin_amdgcn_sched_barrier(0)
    Unit cur, nxt; int ui = 0;
    if (!S.next(0, cur)) return;
    f32x4 acc[2][2][4][2];
#pragma unroll
    for (int a = 0; a < 2; ++a)
#pragma unroll
        for (int b = 0; b < 2; ++b)
#pragma unroll
            for (int m = 0; m < 4; ++m)
#pragma unroll
                for (int n = 0; n < 2; ++n) acc[a][b][m][n] = (f32x4){0.f, 0.f, 0.f, 0.f};
    bf16x8 At[4][2], B0[2][2], B1[2][2];
    const char* cA = (const char*)g.A + (size_t)cur.pm * tstepA; const char* cB = (const char*)g.Bt + (size_t)cur.pn * tstepB;
    S.a_ready(cur);
    if constexpr (SP2) {
        PG8_STAGE(PG8_SB(0, 0), cB, voffB); PG8_STAGE(PG8_SB(0, 1), cB + hstepB, voffB); PG8_STAGE(PG8_SA(0, 0), cA, voffA); PG8_STAGE(PG8_SA(0, 1), cA + hstepA, voffA);
        if (wr == 1) PG8_BAR;
        PG8_WAIT_V(2); PG8_BAR;
        PG8_STAGE(PG8_SB(1, 0), cB + kstep, voffB); PG8_STAGE(PG8_SA(1, 0), cA + kstep, voffA); PG8_STAGE(PG8_SB(1, 1), cB + hstepB + kstep, voffB);
        PG8_WAIT_V(6); PG8_BAR;
    } else {
        PG8_STAGE(PG8_SB(0, 0), cB, voffB); PG8_STAGE(PG8_SA(0, 0), cA, voffA); PG8_STAGE(PG8_SB(0, 1), cB + hstepB, voffB); PG8_STAGE(PG8_SA(0, 1), cA + hstepA, voffA);
        if (wr == 1) PG8_BAR;
        PG8_WAIT_V(4); PG8_BAR;
        PG8_STAGE(PG8_SB(1, 0), cB + kstep, voffB); PG8_STAGE(PG8_SA(1, 0), cA + kstep, voffA); PG8_STAGE(PG8_SB(1, 1), cB + hstepB + kstep, voffB);
        PG8_WAIT_V(6); PG8_BAR;
    }
    for (;;) {
        const bool has_next = S.next(ui + 1, nxt);
        const char* nA = has_next ? (const char*)g.A + (size_t)nxt.pm * tstepA : cA; const char* nB = has_next ? (const char*)g.Bt + (size_t)nxt.pn * tstepB : cB;
        for (int t = 0; t < nt; t += 2) {
            const bool last = (t == nt - 2);
            const char* a1 = cA + (size_t)(t + 1) * kstep;
            const char* a2 = last ? nA : cA + (size_t)(t + 2) * kstep; const char* b2 = last ? nB : cB + (size_t)(t + 2) * kstep;
            const char* a3 = a2 + kstep; const char* b3 = b2 + kstep;
            if (last && has_next) S.a_ready(nxt);
            if constexpr (SP2) {
            PG8_LDB(B0, 0, 0); PG8_LDB(B1, 0, 1); PG8_SCHED; PG8_LDA(At, 0, 0); PG8_STAGE(PG8_SA(1, 1), a1 + hstepA, voffA);
            PG8_WAIT_V(8); PG8_WAIT_L(0); PG8_BAR; PG8_MMA(0, 0, At, B0); PG8_MMA(0, 1, At, B1); PG8_BAR; PG8_SCHED;
            PG8_LDA(At, 0, 1); PG8_STAGE(PG8_SB(0, 0), b2, voffB); PG8_STAGE(PG8_SB(0, 1), b2 + hstepB, voffB); PG8_STAGE(PG8_SA(0, 0), a2, voffA);
            PG8_WAIT_V(8); PG8_WAIT_L(0); PG8_BAR; PG8_MMA(1, 0, At, B0); PG8_MMA(1, 1, At, B1); PG8_BAR; PG8_SCHED;
            PG8_LDB(B0, 1, 0); PG8_LDB(B1, 1, 1); PG8_SCHED; PG8_LDA(At, 1, 0); PG8_STAGE(PG8_SA(0, 1), a2 + hstepA, voffA);
            PG8_WAIT_V(8); PG8_WAIT_L(0); PG8_BAR; PG8_MMA(0, 0, At, B0); PG8_MMA(0, 1, At, B1); PG8_BAR; PG8_SCHED;
            PG8_LDA(At, 1, 1); PG8_STAGE(PG8_SB(1, 0), b3, voffB); PG8_STAGE(PG8_SB(1, 1), b3 + hstepB, voffB); PG8_STAGE(PG8_SA(1, 0), a3, voffA);
            PG8_WAIT_V(8); PG8_WAIT_L(0); PG8_BAR; PG8_MMA(1, 0, At, B0); PG8_MMA(1, 1, At, B1); PG8_BAR; PG8_SCHED;
            } else {
            PG8_LDB(B0, 0, 0); PG8_SCHED; PG8_LDA(At, 0, 0); PG8_STAGE(PG8_SA(1, 1), a1 + hstepA, voffA);
            PG8_WAIT_L(8); PG8_BAR; PG8_WAIT_L(0); PG8_MMA(0, 0, At, B0); PG8_BAR; PG8_SCHED;
            PG8_LDB(B1, 0, 1); PG8_STAGE(PG8_SB(0, 0), b2, voffB);
            PG8_BAR; PG8_WAIT_L(0); PG8_MMA(0, 1, At, B1); PG8_BAR;
            PG8_LDA(At, 0, 1); PG8_STAGE(PG8_SA(0, 0), a2, voffA);
            PG8_BAR; PG8_WAIT_L(0); PG8_MMA(1, 0, At, B0); PG8_BAR; PG8_SCHED;
            PG8_STAGE(PG8_SB(0, 1), b2 + hstepB, voffB);
            PG8_WAIT_V(6); PG8_BAR; PG8_MMA(1, 1, At, B1); PG8_BAR;
            PG8_LDB(B0, 1, 0); PG8_SCHED; PG8_LDA(At, 1, 0); PG8_STAGE(PG8_SA(0, 1), a2 + hstepA, voffA);
            PG8_WAIT_L(8); PG8_BAR; PG8_WAIT_L(0); PG8_MMA(0, 0, At, B0); PG8_BAR; PG8_SCHED;
            PG8_LDB(B1, 1, 1); PG8_STAGE(PG8_SB(1, 0), b3, voffB);
            PG8_BAR; PG8_WAIT_L(0); PG8_MMA(0, 1, At, B1); PG8_BAR;
            PG8_LDA(At, 1, 1); PG8_STAGE(PG8_SA(1, 0), a3, voffA);
            PG8_BAR; PG8_WAIT_L(0); PG8_MMA(1, 0, At, B0); PG8_BAR; PG8_SCHED;
            PG8_STAGE(PG8_SB(1, 1), b3 + hstepB, voffB);
            PG8_WAIT_V(6); PG8_BAR; PG8_MMA(1, 1, At, B1); PG8_BAR;
            }
        }
        if constexpr (ALIGN_EPI) { if (wr == 0) PG8_BAR; }
        if constexpr (!Epi::AFTER_DRAIN) { E(acc, cur, wr, wc, fr, fq); S.done(cur); }
        if (!has_next) break;
#pragma unroll
        for (int a = 0; a < 2; ++a)
#pragma unroll
            for (int b = 0; b < 2; ++b)
#pragma unroll
                for (int m = 0; m < 4; ++m)
#pragma unroll
                    for (int n = 0; n < 2; ++n) acc[a][b][m][n] = (f32x4){0.f, 0.f, 0.f, 0.f};
        cur = nxt; cA = nA; cB = nB; ++ui;
        if constexpr (ALIGN_EPI) { if (wr == 1) PG8_BAR; }
    }
    PG8_WAIT_V(0);
    if constexpr (!ALIGN_EPI) { if (wr == 0) PG8_BAR; }
    PG8_BAR;
    if constexpr (Epi::AFTER_DRAIN) { E.fused(acc, cur, wr, wc, fr, fq, lds, wid, lane); S.done(cur); }
#undef PG8_SA
#undef PG8_SB
#undef PG8_STAGE
#undef PG8_LDA
#undef PG8_LDB
#undef PG8_MMA
#undef PG8_WAIT_V
#undef PG8_WAIT_L
#undef PG8_BAR
#undef PG8_SCHED
}
}
#ifndef PG8_SP2
#define PG8_SP2 true
#endif
#ifndef PG8_ALIGN
#define PG8_ALIGN true
#endif
#define LAS __attribute__((address_space(3)))
typedef unsigned short bf16;
typedef short bf16x8 __attribute__((ext_vector_type(8)));
typedef short s16x4 __attribute__((ext_vector_type(4)));
typedef float f32x4 __attribute__((ext_vector_type(4)));
typedef float f32x16 __attribute__((ext_vector_type(16)));
typedef unsigned v4u __attribute__((ext_vector_type(4)));
typedef unsigned v2u __attribute__((ext_vector_type(2)));
using pg8::cvtpk;
constexpr int NWAVES = 8, NTHR = 512;
constexpr int BATCH = 8, SEQ = 4096, D = 1024, M = BATCH * SEQ, FF = 2816, NMOD = 6 * D;
constexpr int HW = 8192;
constexpr int C_GQ = 0, C_GK = 512, C_GV = 1024, C_GG = 2048, C_SQ = 3072, C_SK = 4096, C_SV = 5120, C_MA = 6144, C_MB = 7168;
constexpr int NIN = 8448;
constexpr int C_U2 = 0, C_ACT = 1024;
constexpr int C_R = 4096, C_X1 = 6144;
constexpr float LN_EPS = 1e-5f, ALPHA = 1.189207115002721f;
constexpr float QK_SCALE = 0.08838834764831845f;
constexpr size_t MiB = 1u << 20;
constexpr size_t DO_U1 = 0, DO_WIN = 64 * MiB, DO_WOUT = 81 * MiB, DO_WFFIN = 85 * MiB, DO_WFFOUT = 96 * MiB, DO_GA = 102 * MiB, DO_MODP = 103 * MiB, DO_MODF = 106 * MiB;
static_assert(DO_WIN + (size_t)NIN * D * 2 <= DO_WOUT && DO_WOUT + (size_t)D * 2048 * 2 <= DO_WFFIN && DO_WFFIN + (size_t)2 * FF * D * 2 <= DO_WFFOUT && DO_WFFOUT + (size_t)D * FF * 2 <= DO_GA &&
              DO_GA + (size_t)M * 16 * 2 <= DO_MODP && DO_MODP + (size_t)16 * BATCH * NMOD * 4 <= DO_MODF && DO_MODF + (size_t)BATCH * NMOD * 4 <= 128 * MiB, "d_out scratch map");
constexpr int LDS_BYTES = 147456;

__device__ __forceinline__ float bf2f(unsigned short u) { return __uint_as_float((unsigned)u << 16); }
__device__ __forceinline__ f32x4 bf4_to_f32(v2u p) { return (f32x4){__uint_as_float(p.x << 16), __uint_as_float(p.x & 0xffff0000u), __uint_as_float(p.y << 16), __uint_as_float(p.y & 0xffff0000u)}; }
__device__ __forceinline__ float wave_sum(float v) {
#pragma unroll
    for (int o = 1; o < 64; o <<= 1) v += __shfl_xor(v, o);
    return v;
}
__device__ __forceinline__ int crow(int reg, int h) { return (reg & 3) + 8 * (reg >> 2) + 4 * h; }
#define MFMA32(a, b, c) __builtin_amdgcn_mfma_f32_32x32x16_bf16((a), (b), (c), 0, 0, 0)
__device__ __forceinline__ bf16x8 pack8(float a0, float a1, float a2, float a3, float a4, float a5, float a6, float a7) {
    v4u p; p.x = cvtpk(a0, a1); p.y = cvtpk(a2, a3); p.z = cvtpk(a4, a5); p.w = cvtpk(a6, a7); return __builtin_bit_cast(bf16x8, p);
}
#define PACK_STEP(x, s) pack8((x)[8 * (s)], (x)[8 * (s) + 1], (x)[8 * (s) + 2], (x)[8 * (s) + 3], (x)[8 * (s) + 4], (x)[8 * (s) + 5], (x)[8 * (s) + 6], (x)[8 * (s) + 7])
typedef short v4i16_t __attribute__((ext_vector_type(4)));
__device__ __forceinline__ s16x4 trd(const LAS unsigned char* p) { return __builtin_bit_cast(s16x4, __builtin_amdgcn_ds_read_tr16_b64_v4i16((LAS v4i16_t*)p)); }
__device__ __forceinline__ bf16x8 trfrag(const LAS unsigned char* p, int stride8) { const s16x4 lo = trd(p), hi = trd(p + stride8); return __builtin_shufflevector(lo, hi, 0, 1, 2, 3, 4, 5, 6, 7); }
constexpr float LOG2E = 1.4426950408889634f;
__device__ __forceinline__ float ex2(float x) { return __builtin_amdgcn_exp2f(x); }
__device__ __forceinline__ float lg2(float x) { return __builtin_amdgcn_logf(x); }
__device__ __forceinline__ float sigmoidf_(float x) { return __builtin_amdgcn_rcpf(1.0f + ex2(-x * LOG2E)); }
__device__ __forceinline__ float softplus2(float z2) { return fmaxf(z2, 0.f) + lg2(1.0f + ex2(-fabsf(z2))); }

__device__ __forceinline__ int tr_srccol(int d, int map) {
    if (map == 0) return d < 3072 ? d : (d < 8192 ? d + 16 : (d < 8208 ? 3072 + (d - 8192) : -1));
    if (map == 1) { const int pn = d >> 8, j = d & 255; return j < 128 ? 128 * pn + j : FF + 128 * pn + (j - 128); }
    return d;
}
__device__ __forceinline__ void transpose_item(const float* W, int Nsrc, bf16* WT, int ldw, int d0, int k0, int map, bool dup, LAS float* scr, int lane) {
    const int cgp = lane & 7, kr = lane >> 3; const int sc = tr_srccol(d0 + 4 * cgp, map);
#pragma unroll
    for (int i = 0; i < 8; ++i) { const int kk = kr + 8 * i; const f32x4 v = sc >= 0 ? *(const f32x4*)(W + (size_t)(k0 + kk) * Nsrc + sc) : (f32x4){0.f, 0.f, 0.f, 0.f};
        LAS float* p = scr + kk * 33 + 4 * cgp; p[0] = v.x; p[1] = v.y; p[2] = v.z; p[3] = v.w; }
    asm volatile("s_waitcnt lgkmcnt(0)" ::: "memory");
    const int c = lane & 7;
#pragma unroll
    for (int j = 0; j < 4; ++j) { const int n = (lane >> 3) + 8 * j; const LAS float* s = scr + (8 * c) * 33 + n;
        v4u o; o.x = cvtpk(s[0 * 33], s[1 * 33]); o.y = cvtpk(s[2 * 33], s[3 * 33]); o.z = cvtpk(s[4 * 33], s[5 * 33]); o.w = cvtpk(s[6 * 33], s[7 * 33]);
        bf16* dst = WT + (size_t)(d0 + n) * ldw + k0 + 8 * c; *(v4u*)dst = o; if (dup) *(v4u*)(dst + 1024) = o; }
    asm volatile("s_waitcnt lgkmcnt(0)" ::: "memory");
}

struct Args { const float* in[15]; float* out; unsigned char* ws; };

__device__ __forceinline__ void row_stats(f32x4 (&v)[4], float& rstd) {
    float s = 0.f;
#pragma unroll
    for (int j = 0; j < 4; ++j) s += (v[j].x + v[j].y) + (v[j].z + v[j].w);
    const float mean = wave_sum(s) * (1.f / D); float s2 = 0.f;
#pragma unroll
    for (int j = 0; j < 4; ++j) { v[j] = v[j] - mean; s2 += (v[j].x * v[j].x + v[j].y * v[j].y) + (v[j].z * v[j].z + v[j].w * v[j].w); }
    rstd = 1.0f / sqrtf(wave_sum(s2) * (1.f / D) + LN_EPS);
}

constexpr int SB_KS = 272;
__device__ __forceinline__ void sb_unit(bf16* H, LAS unsigned char* wl, int b, int hd, int qt, int lane) {
    const int n = lane & 31, hh = lane >> 5, i16 = lane & 15, tq = i16 >> 2, tp = i16 & 3, blk = (lane >> 4) & 1;
    const size_t rowbase = (size_t)b * SEQ;
    bf16x8 qf[8];
    { const bf16* qp = H + (rowbase + 32 * qt + n) * HW + C_SQ + hd * 128 + 8 * hh;
#pragma unroll
      for (int s = 0; s < 8; ++s) qf[s] = *(const bf16x8*)(qp + 16 * s); }
    f32x16 oT[4];
#pragma unroll
    for (int cb = 0; cb < 4; ++cb)
#pragma unroll
        for (int r = 0; r < 16; ++r) oT[cb][r] = 0.f;
    float R = 0.f;
    LAS unsigned char* Kl = wl; LAS unsigned char* Vl = wl + 32 * SB_KS;
    const LAS unsigned char* kread = Kl + n * SB_KS + 16 * hh;
    const LAS unsigned char* vread = Vl + (4 * hh + tq) * SB_KS + (16 * blk + 4 * tp) * 2;
    v4u kreg[8], vreg[8];
    { const bf16* kp = H + (rowbase + 32 * qt) * HW + C_SK + hd * 128; const bf16* vp = kp + (C_SV - C_SK);
#pragma unroll
      for (int i = 0; i < 8; ++i) { const int id = lane + 64 * i, row = id >> 4, ch = id & 15; kreg[i] = *(const v4u*)(kp + (size_t)row * HW + ch * 8); vreg[i] = *(const v4u*)(vp + (size_t)row * HW + ch * 8); } }
    for (int kt = qt; kt >= 0; --kt) {
#pragma unroll
        for (int i = 0; i < 8; ++i) { const int id = lane + 64 * i, row = id >> 4, ch = id & 15;
            *(LAS v4u*)(Kl + row * SB_KS + ch * 16) = kreg[i]; *(LAS v4u*)(Vl + row * SB_KS + ch * 16) = vreg[i]; }
        if (kt > 0) { const bf16* kp = H + (rowbase + 32 * (kt - 1)) * HW + C_SK + hd * 128; const bf16* vp = kp + (C_SV - C_SK);
#pragma unroll
            for (int i = 0; i < 8; ++i) { const int id = lane + 64 * i, row = id >> 4, ch = id & 15; kreg[i] = *(const v4u*)(kp + (size_t)row * HW + ch * 8); vreg[i] = *(const v4u*)(vp + (size_t)row * HW + ch * 8); } }
        f32x16 st, st1;
#pragma unroll
        for (int r = 0; r < 16; ++r) { st[r] = 0.f; st1[r] = 0.f; }
#pragma unroll
        for (int s = 0; s < 8; s += 2) { const bf16x8 kf = *(const LAS bf16x8*)(kread + 32 * s), kf1 = *(const LAS bf16x8*)(kread + 32 * s + 32); st = MFMA32(kf, qf[s], st); st1 = MFMA32(kf1, qf[s + 1], st1); }
#pragma unroll
        for (int r = 0; r < 16; ++r) st[r] += st1[r];
        const bool diag = (kt == qt);
        float sp[16], w[16];
#pragma unroll
        for (int r = 0; r < 16; ++r) { const float z = st[r] * (QK_SCALE * LOG2E); const float spv = softplus2(z); const bool valid = !diag || (crow(r, hh) < n);
            sp[r] = valid ? spv : 0.f; w[r] = valid ? (z - spv) : -1.0e30f; }
        float own[4], par[4];
#pragma unroll
        for (int g = 0; g < 4; ++g) own[g] = (sp[4 * g] + sp[4 * g + 1]) + (sp[4 * g + 2] + sp[4 * g + 3]);
#pragma unroll
        for (int g = 0; g < 4; ++g) par[g] = __shfl_xor(own[g], 32);
        float U[4];
        U[3] = 0.f; U[2] = own[3] + par[3]; U[1] = U[2] + (own[2] + par[2]); U[0] = U[1] + (own[1] + par[1]);
        const float total = U[0] + (own[0] + par[0]);
#pragma unroll
        for (int g = 0; g < 4; ++g) { float after = R + U[g] + (hh == 0 ? par[g] : 0.f);
            w[4 * g + 3] = ex2(w[4 * g + 3] - after); after += sp[4 * g + 3];
            w[4 * g + 2] = ex2(w[4 * g + 2] - after); after += sp[4 * g + 2];
            w[4 * g + 1] = ex2(w[4 * g + 1] - after); after += sp[4 * g + 1];
            w[4 * g] = ex2(w[4 * g] - after); }
        R += total;
        const bf16x8 wf0 = pack8(w[0], w[1], w[2], w[3], w[4], w[5], w[6], w[7]), wf1 = pack8(w[8], w[9], w[10], w[11], w[12], w[13], w[14], w[15]);
#pragma unroll
        for (int cb = 0; cb < 4; ++cb) {
            const bf16x8 v0 = trfrag(vread + 64 * cb, 8 * SB_KS), v1 = trfrag(vread + 16 * SB_KS + 64 * cb, 8 * SB_KS);
            oT[cb] = MFMA32(v0, wf0, oT[cb]); oT[cb] = MFMA32(v1, wf1, oT[cb]); }
        asm volatile("s_waitcnt lgkmcnt(0)" ::: "memory");
        if (__ballot(R <= 150.1f) == 0ull) break;
    }
    const size_t mrow = (rowbase + 32 * qt + n) * HW;
#pragma unroll
    for (int cb = 0; cb < 4; ++cb)
#pragma unroll
        for (int g = 0; g < 4; ++g) { const int dh0 = hd * 128 + 32 * cb + 8 * g + 4 * hh;
            const v2u mb = *(const v2u*)(H + mrow + C_MB + dh0);
            const float g0 = sigmoidf_(__uint_as_float(mb.x << 16)), g1 = sigmoidf_(__uint_as_float(mb.x & 0xffff0000u)), g2 = sigmoidf_(__uint_as_float(mb.y << 16)), g3 = sigmoidf_(__uint_as_float(mb.y & 0xffff0000u));
            v2u o; o.x = cvtpk(oT[cb][4 * g] * g0, oT[cb][4 * g + 1] * g1); o.y = cvtpk(oT[cb][4 * g + 2] * g2, oT[cb][4 * g + 3] * g3);
            *(v2u*)(H + mrow + C_SQ + dh0) = o; }
}
constexpr int GL_QS = 272, GL_VS = 528;
constexpr int GL_QE = 0, GL_KE = 64 * GL_QS, GL_KD = 2 * 64 * GL_QS, GL_VV = 3 * 64 * GL_QS, GL_GA = GL_VV + 64 * GL_VS, GL_SEG = GL_GA + 4096, GL_EB = GL_SEG + 2048, GL_SSQ = GL_EB + 512, GL_WUP = GL_SSQ + 2048, GL_END = GL_WUP + 8192;
static_assert(GL_END <= 131072, "GLA LDS map");
constexpr int GL_NSEG = 8, GL_SEGCH = (SEQ / 64) / GL_NSEG, GL_STATE = 8 * 4 * 16 * 64;
template <bool FULL>
__device__ __forceinline__ void gla_seg(bf16* H, const bf16* GA, const float* w_up, const float* b_alpha, const float* gng, float* Lst, float* Lsum, LAS unsigned char* lds, int unit, int tid) {
    const int b = unit >> 5, hg = (unit >> 3) & 3, sj = unit & 7;
    const int lane = tid & 63, wave = tid >> 6, n = lane & 31, hh = lane >> 5, i16 = lane & 15, tq = i16 >> 2, tp = i16 & 3, blk = (lane >> 4) & 1;
    const int d = tid & 127, seg = tid >> 7;
    LAS float* WUP = (LAS float*)(lds + GL_WUP);
#pragma unroll
    for (int r = 0; r < 4; ++r) WUP[(4 * seg + r) * 128 + d] = w_up[(4 * seg + r) * 512 + hg * 128 + d];
    f32x16 sacc[4];
#pragma unroll
    for (int db = 0; db < 4; ++db)
#pragma unroll
        for (int r = 0; r < 16; ++r) sacc[db][r] = 0.f;
    LAS float* GAc = (LAS float*)(lds + GL_GA); LAS float* SEG = (LAS float*)(lds + GL_SEG); LAS float* EB = (LAS float*)(lds + GL_EB); LAS float* SSQ = (LAS float*)(lds + GL_SSQ);
    const LAS unsigned char* vtr_base = lds + GL_VV + (4 * hh + tq) * GL_VS + (32 * wave + 16 * blk + 4 * tp) * 2;
    const LAS unsigned char* kdtr_base = lds + GL_KD + (4 * hh + tq) * GL_QS + (16 * blk + 4 * tp) * 2;
    float lsum = 0.f;
    if (FULL && sj > 0) {
        LAS float* EBA = SEG;
        __syncthreads();
        for (int e = tid; e < sj * 128; e += NTHR) EBA[e] = ex2(Lsum[(unit - sj) * 128 + e]);
        __syncthreads();
        for (int jp = 0; jp < sj; ++jp) { const float* Lp = Lst + (size_t)(unit - sj + jp) * GL_STATE + (size_t)wave * 4 * 16 * 64 + lane;
#pragma unroll
            for (int db = 0; db < 4; ++db)
#pragma unroll
                for (int g = 0; g < 4; ++g) { const f32x4 e4 = *(const LAS f32x4*)(EBA + jp * 128 + 32 * db + 8 * g + 4 * hh);
#pragma unroll
                    for (int j = 0; j < 4; ++j) sacc[db][4 * g + j] = sacc[db][4 * g + j] * e4[j] + Lp[(db * 16 + 4 * g + j) * 64]; } }
        __syncthreads();
    }
    v4u qpre[2], kpre[2], vpre[4]; unsigned gapre;
#define GLA_FETCH(cc) do { const size_t mm = (size_t)b * SEQ + 64 * (size_t)(cc); \
        _Pragma("unroll") for (int i = 0; i < 2; ++i) { const int id = tid + NTHR * i, row = id >> 4, ch = id & 15; const bf16* rp = H + (mm + row) * HW + hg * 128 + ch * 8; \
            if (FULL) qpre[i] = *(const v4u*)(rp + C_GQ); kpre[i] = *(const v4u*)(rp + C_GK); } \
        _Pragma("unroll") for (int i = 0; i < 4; ++i) { const int id = tid + NTHR * i, row = id >> 5, ch = id & 31; vpre[i] = *(const v4u*)(H + (mm + row) * HW + C_GV + hg * 256 + ch * 8); } \
        gapre = *(const unsigned*)(GA + mm * 16 + 2 * tid); } while (0)
    GLA_FETCH(sj * GL_SEGCH);
    for (int c = sj * GL_SEGCH; c < (sj + 1) * GL_SEGCH; ++c) {
        const size_t m0 = (size_t)b * SEQ + 64 * c;
#pragma unroll
        for (int i = 0; i < 2; ++i) { const int id = tid + NTHR * i, row = id >> 4, ch = id & 15;
            if (FULL) *(LAS v4u*)(lds + GL_QE + row * GL_QS + ch * 16) = qpre[i];
            *(LAS v4u*)(lds + GL_KE + row * GL_QS + ch * 16) = kpre[i]; }
#pragma unroll
        for (int i = 0; i < 4; ++i) { const int id = tid + NTHR * i, row = id >> 5, ch = id & 31; *(LAS v4u*)(lds + GL_VV + row * GL_VS + ch * 16) = vpre[i]; }
        GAc[2 * tid] = __uint_as_float(gapre << 16); GAc[2 * tid + 1] = __uint_as_float(gapre & 0xffff0000u);
        __syncthreads();
        float bb[16]; float run = 0.f; float wup[16]; const float bal = b_alpha[hg * 128 + d];
#pragma unroll
        for (int r = 0; r < 16; ++r) wup[r] = WUP[r * 128 + d];
#pragma unroll
        for (int ii = 0; ii < 16; ++ii) { const LAS f32x4* g4 = (const LAS f32x4*)(GAc + (16 * seg + ii) * 16); float z = bal;
#pragma unroll
            for (int r4 = 0; r4 < 4; ++r4) { const f32x4 gv = g4[r4]; z += gv.x * wup[4 * r4] + gv.y * wup[4 * r4 + 1] + gv.z * wup[4 * r4 + 2] + gv.w * wup[4 * r4 + 3]; }
            run += -softplus2(-z * LOG2E) * (1.0f / 16.0f); bb[ii] = run; }
        SEG[seg * 128 + d] = run;
        __syncthreads();
        { const float t0 = SEG[d], t1 = SEG[128 + d], t2 = SEG[256 + d], t3 = SEG[384 + d];
          const float off = (seg > 0 ? t0 : 0.f) + (seg > 1 ? t1 : 0.f) + (seg > 2 ? t2 : 0.f); const float blast = ((t0 + t1) + t2) + t3;
          if (seg == 0) { EB[d] = ex2(blast); lsum += blast; }
#pragma unroll
          for (int ii = 0; ii < 16; ++ii) { const int i = 16 * seg + ii; const float bi = bb[ii] + off; const float qv = FULL ? bf2f(*(const LAS unsigned short*)(lds + GL_QE + i * GL_QS + d * 2)) : 0.f, kv = bf2f(*(const LAS unsigned short*)(lds + GL_KE + i * GL_QS + d * 2));
              if (FULL) { *(LAS unsigned short*)(lds + GL_QE + i * GL_QS + d * 2) = (unsigned short)(cvtpk(qv * QK_SCALE * ex2(bi), 0.f) & 0xffffu);
                          *(LAS unsigned short*)(lds + GL_KE + i * GL_QS + d * 2) = (unsigned short)(cvtpk(kv * ex2(-bi), 0.f) & 0xffffu); }
              *(LAS unsigned short*)(lds + GL_KD + i * GL_QS + d * 2) = (unsigned short)(cvtpk(kv * ex2(blast - bi), 0.f) & 0xffffu); } }
        __syncthreads();
        if (c + 1 < (sj + 1) * GL_SEGCH) GLA_FETCH(c + 1);
        f32x16 oT[2];
#pragma unroll
        for (int tb = 0; tb < 2; ++tb)
#pragma unroll
            for (int r = 0; r < 16; ++r) oT[tb][r] = 0.f;
        if (FULL) {
#pragma unroll
        for (int db = 0; db < 4; ++db)
#pragma unroll
            for (int s = 0; s < 2; ++s) { const bf16x8 sf = PACK_STEP(sacc[db], s);
#pragma unroll
                for (int tb = 0; tb < 2; ++tb) { const LAS unsigned char* qb = lds + GL_QE + (32 * tb + n) * GL_QS + (32 * db + 16 * s + 4 * hh) * 2;
                    const s16x4 lo = *(const LAS s16x4*)qb, hi = *(const LAS s16x4*)(qb + 16); const bf16x8 bq = __builtin_shufflevector(lo, hi, 0, 1, 2, 3, 4, 5, 6, 7);
                    oT[tb] = MFMA32(sf, bq, oT[tb]); } }
        }
        bf16x8 vf[2][2];
#pragma unroll
        for (int sb = 0; sb < 2; ++sb)
#pragma unroll
            for (int s2 = 0; s2 < 2; ++s2) vf[sb][s2] = trfrag(vtr_base + (32 * sb + 16 * s2) * GL_VS, 8 * GL_VS);
        if (FULL) {
#pragma unroll
        for (int blk3 = 0; blk3 < 3; ++blk3) { const int sb = blk3 >> 1, tb = (blk3 + 1) >> 1;
            f32x16 pt;
#pragma unroll
            for (int r = 0; r < 16; ++r) pt[r] = 0.f;
#pragma unroll
            for (int ks = 0; ks < 8; ++ks) { const bf16x8 ka = *(const LAS bf16x8*)(lds + GL_KE + (32 * sb + n) * GL_QS + (16 * ks + 8 * hh) * 2);
                const bf16x8 qb = *(const LAS bf16x8*)(lds + GL_QE + (32 * tb + n) * GL_QS + (16 * ks + 8 * hh) * 2); pt = MFMA32(ka, qb, pt); }
            if (sb == tb) {
#pragma unroll
                for (int r = 0; r < 16; ++r) pt[r] = (crow(r, hh) <= n) ? pt[r] : 0.f; }
            const bf16x8 p0 = PACK_STEP(pt, 0), p1 = PACK_STEP(pt, 1);
            oT[tb] = MFMA32(vf[sb][0], p0, oT[tb]); oT[tb] = MFMA32(vf[sb][1], p1, oT[tb]); }
        }
#pragma unroll
        for (int db = 0; db < 4; ++db) {
#pragma unroll
            for (int g = 0; g < 4; ++g) { const f32x4 e4 = *(const LAS f32x4*)(EB + 32 * db + 8 * g + 4 * hh);
                sacc[db][4 * g] *= e4.x; sacc[db][4 * g + 1] *= e4.y; sacc[db][4 * g + 2] *= e4.z; sacc[db][4 * g + 3] *= e4.w; }
#pragma unroll
            for (int sb = 0; sb < 2; ++sb)
#pragma unroll
                for (int s2 = 0; s2 < 2; ++s2) { const bf16x8 kdf = trfrag(kdtr_base + (32 * sb + 16 * s2) * GL_QS + 64 * db, 8 * GL_QS); sacc[db] = MFMA32(kdf, vf[sb][s2], sacc[db]); } }
        if (!FULL) { __syncthreads(); continue; }
#pragma unroll
        for (int tb = 0; tb < 2; ++tb) { float ss = 0.f;
#pragma unroll
            for (int r = 0; r < 16; ++r) ss += oT[tb][r] * oT[tb][r];
            ss += __shfl_xor(ss, 32); if (hh == 0) SSQ[wave * 64 + 32 * tb + n] = ss; }
        __syncthreads();
#pragma unroll
        for (int tb = 0; tb < 2; ++tb) { const int t = 32 * tb + n; float tot = 0.f;
#pragma unroll
            for (int w8 = 0; w8 < 8; ++w8) tot += SSQ[w8 * 64 + t];
            const float rstd = 1.0f / sqrtf(tot * (1.0f / 256.0f) + LN_EPS); bf16* rowp = H + (m0 + t) * HW;
#pragma unroll
            for (int g = 0; g < 4; ++g) { const int col = hg * 256 + 32 * wave + 8 * g + 4 * hh;
                const v2u gg = *(const v2u*)(rowp + C_GG + col), ma = *(const v2u*)(rowp + C_MA + col), os = *(const v2u*)(rowp + C_SQ + col); const f32x4 gn = *(const f32x4*)(gng + col);
                const float x0 = __uint_as_float(gg.x << 16), x1 = __uint_as_float(gg.x & 0xffff0000u), x2 = __uint_as_float(gg.y << 16), x3 = __uint_as_float(gg.y & 0xffff0000u);
                const float a0 = __uint_as_float(ma.x << 16), a1 = __uint_as_float(ma.x & 0xffff0000u), a2 = __uint_as_float(ma.y << 16), a3 = __uint_as_float(ma.y & 0xffff0000u);
                const float o0 = oT[tb][4 * g] * rstd * gn.x * (x0 * sigmoidf_(x0)) * sigmoidf_(a0), o1 = oT[tb][4 * g + 1] * rstd * gn.y * (x1 * sigmoidf_(x1)) * sigmoidf_(a1);
                const float o2 = oT[tb][4 * g + 2] * rstd * gn.z * (x2 * sigmoidf_(x2)) * sigmoidf_(a2), o3 = oT[tb][4 * g + 3] * rstd * gn.w * (x3 * sigmoidf_(x3)) * sigmoidf_(a3);
                v2u o; o.x = cvtpk(o0 + __uint_as_float(os.x << 16), o1 + __uint_as_float(os.x & 0xffff0000u)); o.y = cvtpk(o2 + __uint_as_float(os.y << 16), o3 + __uint_as_float(os.y & 0xffff0000u)); *(v2u*)(rowp + C_GG + col) = o; } }
    }
    if (!FULL) {
        float* Lp = Lst + (size_t)unit * GL_STATE + (size_t)wave * 4 * 16 * 64 + lane;
#pragma unroll
        for (int db = 0; db < 4; ++db)
#pragma unroll
            for (int r = 0; r < 16; ++r) Lp[(db * 16 + r) * 64] = sacc[db][r];
        if (tid < 128) Lsum[unit * 128 + tid] = lsum;
    }
}
#define RLX_AGENT __ATOMIC_RELAXED, __HIP_MEMORY_SCOPE_AGENT
#define XB_TMO      128
#define XB_XCNT(j)  (256  + 64 * (j))
#define XB_XSUB(j)  (1280 + 64 * (j))
#define XB_XGEN(j)  (2304 + 64 * (j))
#define XB_TOP      3328
#define XB_TOPGEN   3392
#define XCD_BAR_WORDS 3456
#define XB_SPIN_CAP (1u << 18)
#define XBW(bar, i) ((bar) + (size_t)((unsigned)(i) >> 7) * xb_stride + ((unsigned)(i) & 127u))

__device__ __forceinline__ unsigned xb_ld(unsigned* p)              { return __hip_atomic_load(p, __ATOMIC_RELAXED, __HIP_MEMORY_SCOPE_AGENT); }
__device__ __forceinline__ unsigned xb_add(unsigned* p, unsigned v) { return __hip_atomic_fetch_add(p, v, __ATOMIC_RELAXED, __HIP_MEMORY_SCOPE_AGENT); }
__device__ __forceinline__ unsigned xb_xcc_id() { return (unsigned)__builtin_amdgcn_s_getreg((3 << 11) | 20) & 0xFu; }
#define XB_SPIN(cond, bar) do { unsigned _sp = 0; while (cond) { __builtin_amdgcn_s_sleep(1); \
    if ((++_sp & 255u) == 0u) { if (xb_ld(XBW(bar, XB_TMO))) break; if (_sp > XB_SPIN_CAP) { atomicAdd(XBW(bar, XB_TMO), 1u); break; } } } } while (0)

struct XcdBarrier {
    unsigned xb_stride;
    unsigned* bar; unsigned x;
    volatile LAS unsigned* st;
};

__device__ __forceinline__ XcdBarrier xcd_barrier_post(unsigned* bar, volatile LAS unsigned* st, unsigned xb_stride) {
    XcdBarrier b; b.xb_stride = xb_stride; b.bar = bar; b.x = xb_xcc_id(); b.st = st;
    if (threadIdx.x == 0) (void)xb_add(XBW(bar, XB_XCNT(b.x)), 1u);
    return b;
}
__device__ __forceinline__ void xcd_barrier_complete(unsigned* bar, unsigned xb_stride, unsigned x, unsigned& nloc, unsigned& nx) {
    const unsigned G = gridDim.x * gridDim.y * gridDim.z;
    unsigned sum, cnt, mine, sp = 0u;
    for (;;) {
        sum = 0u; cnt = 0u; mine = 0u;
#pragma unroll
        for (unsigned j = 0; j < 16; ++j) { const unsigned c = xb_ld(XBW(bar, XB_XCNT(j))); sum += c; cnt += (c > 0u) ? 1u : 0u; mine = (j == x) ? c : mine; }
        if (sum == G) break;
        __builtin_amdgcn_s_sleep(1);
        if ((++sp & 255u) == 0u) { if (xb_ld(XBW(bar, XB_TMO))) break; if (sp > XB_SPIN_CAP) { atomicAdd(XBW(bar, XB_TMO), 1u); break; } }
    }
    nloc = mine > 0u ? mine : 1u; nx = cnt > 0u ? cnt : 1u;
}

__device__ __forceinline__ void xcd_barrier(const XcdBarrier& b) {
    asm volatile("s_waitcnt vmcnt(0)" ::: "memory");
    __syncthreads();
    if (threadIdx.x == 0) {
        unsigned* bar = b.bar; const unsigned xb_stride = b.xb_stride;
        __builtin_amdgcn_s_waitcnt(0);
        unsigned nloc = b.st[0], nx = b.st[1];
        if (nloc == 0u) { xcd_barrier_complete(bar, xb_stride, b.x, nloc, nx); b.st[0] = nloc; b.st[1] = nx; }
        const unsigned old = xb_add(XBW(bar, XB_XSUB(b.x)), 1u);
        const unsigned gen = old / nloc;
        if (old + 1u == (gen + 1u) * nloc) {
            __builtin_amdgcn_fence(__ATOMIC_RELEASE, "agent");
            asm volatile("s_waitcnt vmcnt(0)" ::: "memory");
            const unsigned og = xb_add(XBW(bar, XB_TOP), 1u);
            const unsigned tg = og / nx;
            if (og + 1u == (tg + 1u) * nx) xb_add(XBW(bar, XB_TOPGEN), 1u);
            else XB_SPIN(xb_ld(XBW(bar, XB_TOPGEN)) == tg, bar);
            __builtin_amdgcn_fence(__ATOMIC_ACQUIRE, "agent");
            xb_add(XBW(bar, XB_XGEN(b.x)), 1u);
            asm volatile("s_waitcnt vmcnt(0)" ::: "memory");
        } else {
            XB_SPIN(xb_ld(XBW(bar, XB_XGEN(b.x))) == gen, bar);
            __builtin_amdgcn_fence(__ATOMIC_ACQUIRE, "agent");
            asm volatile("s_waitcnt vmcnt(0)" ::: "memory");
        }
    }
    __syncthreads();
}

constexpr size_t DO_BAR = 107 * MiB;
constexpr int MISC_OFF = LDS_BYTES - 256;
constexpr unsigned XBB_WORD0 = 1920u, XBB_STRIDE = 4096u;
__global__ void __launch_bounds__(NTHR, 2) fwd_megakernel(Args args) {
    extern __shared__ __attribute__((aligned(16))) unsigned char lds_raw[];
    cg::grid_group grid = cg::this_grid();
    LAS unsigned char* lds = (LAS unsigned char*)lds_raw;
    const int tid = threadIdx.x, lane = tid & 63, wave = __builtin_amdgcn_readfirstlane(tid >> 6);
    const int G = gridDim.x, bx = blockIdx.x;
    const float* x = args.in[0]; const float* cvec = args.in[1]; const float* w_ada = args.in[2]; const float* b_ada = args.in[3]; const float* w_in = args.in[4];
    const float* w_up = args.in[5]; const float* b_alpha = args.in[6]; const float* gng = args.in[7]; const float* w_out = args.in[8];
    const float* ln1_g = args.in[9]; const float* ln1_b = args.in[10]; const float* w_ffin = args.in[11]; const float* w_ffout = args.in[12]; const float* ln2_g = args.in[13]; const float* ln2_b = args.in[14];
    unsigned char* dsc = (unsigned char*)args.out;
    bf16* H = (bf16*)args.ws; float* Hf = (float*)args.ws;
    bf16* U1 = (bf16*)(dsc + DO_U1); bf16* Wt_in = (bf16*)(dsc + DO_WIN); bf16* Wt_out = (bf16*)(dsc + DO_WOUT); bf16* Wt_ffin = (bf16*)(dsc + DO_WFFIN); bf16* Wt_ffout = (bf16*)(dsc + DO_WFFOUT);
    bf16* GA = (bf16*)(dsc + DO_GA); float* Lst = (float*)(dsc + DO_U1); float* Lsum = (float*)(dsc + DO_U1 + 32 * MiB); float* modp = (float*)(dsc + DO_MODP); float* modf = (float*)(dsc + DO_MODF);

    volatile LAS unsigned* MISC = (volatile LAS unsigned*)(lds + MISC_OFF);
    if (tid < 64) MISC[tid] = 0u;
    __syncthreads();
    const XcdBarrier xbar = xcd_barrier_post((unsigned*)(dsc + DO_BAR), MISC, 128u);
    unsigned* const barB = (unsigned*)args.ws + XBB_WORD0;
    {
        LAS float* scr = (LAS float*)(lds + wave * 16384);
        const int gw = bx * NWAVES + wave, NGW = G * NWAVES;
        constexpr int I_ADA = 96 * 16, I_IN = (8224 / 32) * (D / 64), I_OUT = (D / 32) * (D / 64), I_FI = (2 * FF / 32) * (D / 64), I_FO = (D / 32) * (FF / 64);
        constexpr int NITEMS = I_ADA + I_IN + I_OUT + I_FI + I_FO;
        for (int it = gw; it < NITEMS; it += NGW) {
            int r = it;
            if (r < I_ADA) {
                const int cgp = r % 96, ks = r / 96, col = 64 * cgp + lane, k0 = 64 * ks;
                float sc[8], acc[8];
#pragma unroll
                for (int b = 0; b < 8; ++b) { const float cv = cvec[b * D + k0 + lane]; sc[b] = cv * sigmoidf_(cv); acc[b] = 0.f; }
#pragma unroll 8
                for (int kk = 0; kk < 64; ++kk) { const float w = w_ada[(size_t)(k0 + kk) * NMOD + col];
#pragma unroll
                    for (int b = 0; b < 8; ++b) acc[b] += __builtin_bit_cast(float, __builtin_amdgcn_readlane(__builtin_bit_cast(int, sc[b]), kk)) * w; }
#pragma unroll
                for (int b = 0; b < 8; ++b) modp[(size_t)(ks * 8 + b) * NMOD + col] = acc[b];
                continue;
            }
            r -= I_ADA;
            if (r < I_IN) { transpose_item(w_in, 8208, Wt_in, D, 32 * (r % (8224 / 32)), 64 * (r / (8224 / 32)), 0, false, scr, lane); continue; } r -= I_IN;
            if (r < I_OUT) { transpose_item(w_out, D, Wt_out, D, 32 * (r % (D / 32)), 64 * (r / (D / 32)), 2, false, scr, lane); continue; } r -= I_OUT;
            if (r < I_FI) { transpose_item(w_ffin, 2 * FF, Wt_ffin, D, 32 * (r % (2 * FF / 32)), 64 * (r / (2 * FF / 32)), 1, false, scr, lane); continue; } r -= I_FI;
            transpose_item(w_ffout, D, Wt_ffout, FF, 32 * (r % (D / 32)), 64 * (r / (D / 32)), 2, false, scr, lane);
        }
    }
    grid.sync();

    {
        for (int idx = bx * NTHR + tid; idx < BATCH * NMOD; idx += G * NTHR) { const int b = idx / NMOD, j = idx % NMOD; float s = b_ada[j];
#pragma unroll
            for (int ks = 0; ks < 16; ++ks) s += modp[(size_t)(ks * 8 + b) * NMOD + j];
            modf[idx] = s; }
        LAS float* ssh = (LAS float*)lds; LAS float* ssc = ssh + D;
        constexpr int WGA_OFF = 16384, WGA_RS = 2064;
        for (int e = tid; e < 16 * 128; e += NTHR) { const int r = e >> 7, ch = e & 127; *(LAS v4u*)(lds + WGA_OFF + r * WGA_RS + ch * 16) = *(const v4u*)(Wt_in + (size_t)(8192 + r) * D + ch * 8); }
        for (int rg = bx; rg < M / 128; rg += G) {
            const int b = rg / (SEQ / 128);
            __syncthreads();
            for (int j = tid; j < 2 * D; j += NTHR) { float s = b_ada[j];
#pragma unroll
                for (int ks = 0; ks < 16; ++ks) s += modp[(size_t)(ks * 8 + b) * NMOD + j];
                ssh[j] = s; }
            __syncthreads();
            for (int i = 0; i < 16; i += 4) { const size_t row0 = (size_t)rg * 128 + wave * 16 + i; f32x4 v[4][4];
#pragma unroll
                for (int r = 0; r < 4; ++r) { const f32x4* xr = (const f32x4*)(x + (row0 + r) * D) + lane;
#pragma unroll
                    for (int j = 0; j < 4; ++j) v[r][j] = xr[64 * j]; }
#pragma unroll
                for (int r = 0; r < 4; ++r) { float rstd; row_stats(v[r], rstd);
                    unsigned long long* o8 = (unsigned long long*)(U1 + (row0 + r) * D) + lane;
#pragma unroll
                    for (int j = 0; j < 4; ++j) { const int c0 = 4 * lane + 256 * j; const f32x4 sc = *(const LAS f32x4*)(ssc + c0), sh = *(const LAS f32x4*)(ssh + c0);
                        const f32x4 o = v[r][j] * rstd * (sc + 1.0f) + sh; o8[64 * j] = (unsigned long long)cvtpk(o.x, o.y) | ((unsigned long long)cvtpk(o.z, o.w) << 32); } } }
            { asm volatile("s_waitcnt vmcnt(0)" ::: "memory");
              const size_t row0 = (size_t)rg * 128 + wave * 16; const int ar = lane & 15, kq = lane >> 4;
              const bf16* ap = U1 + (row0 + ar) * D + 8 * kq; const LAS unsigned char* bp = lds + WGA_OFF + ar * WGA_RS + 16 * kq;
              pg8::f32x4 acc0 = {0.f, 0.f, 0.f, 0.f}, acc1 = {0.f, 0.f, 0.f, 0.f};
#pragma unroll 4
              for (int s = 0; s < 32; s += 2) { const bf16x8 a0 = *(const bf16x8*)(ap + 32 * s), a1 = *(const bf16x8*)(ap + 32 * s + 32);
                  const bf16x8 b0 = *(const LAS bf16x8*)(bp + 64 * s), b1 = *(const LAS bf16x8*)(bp + 64 * s + 64);
                  acc0 = __builtin_amdgcn_mfma_f32_16x16x32_bf16(a0, b0, acc0, 0, 0, 0); acc1 = __builtin_amdgcn_mfma_f32_16x16x32_bf16(a1, b1, acc1, 0, 0, 0); }
#pragma unroll
              for (int r = 0; r < 4; ++r) GA[(row0 + 4 * kq + r) * 16 + ar] = (bf16)(cvtpk(acc0[r] + acc1[r], 0.f) & 0xffffu); }
        }
    }
    xcd_barrier(xbar);

    { pg8::Gemm g{U1, Wt_in, M, HW, D, D}; pg8::StaticOrder S; S.init(M, HW, G, bx); pg8::EpiH E{H, GA};
      pg8::gemm_phase<pg8::EpiH, pg8::StaticOrder, PG8_ALIGN, PG8_SP2>(lds, g, S, E); }
    xcd_barrier(xbar);

    {
        for (int unit = bx; unit < BATCH * 4 * GL_NSEG; unit += G) { if ((unit & 7) != 7) { int t_ = tid; asm volatile("" : "+v"(t_)); gla_seg<false>(H, GA, w_up, b_alpha, gng, Lst, Lsum, lds, unit, t_); } __syncthreads(); }
        LAS unsigned char* wl = lds + wave * (64 * SB_KS);
        unsigned* sbq = (unsigned*)(dsc + DO_BAR + 8192);
        for (;;) { unsigned u = 0u; if (lane == 0) u = atomicAdd(sbq, 1u); u = (unsigned)__builtin_amdgcn_readfirstlane((int)u); if (u >= (unsigned)(BATCH * 8 * (SEQ / 32))) break;
            const int qt = 127 - (int)(u & 127u), bh = (int)(u >> 7); int l_ = lane; asm volatile("" : "+v"(l_)); sb_unit(H, wl, bh >> 3, bh & 7, qt, l_); }
    }
    xcd_barrier(xbar);
    for (int unit = bx; unit < BATCH * 4 * GL_NSEG; unit += G) { __syncthreads(); int t_ = tid; asm volatile("" : "+v"(t_)); gla_seg<true>(H, GA, w_up, b_alpha, gng, Lst, Lsum, lds, unit, t_); }
    xcd_barrier(xbar);

    { pg8::Gemm g{H + C_GG, Wt_out, M, D, D, HW}; pg8::StaticOrder S; S.init(M, D, G, bx); pg8::EpiRes<false> E{x, D, H + C_R, HW, modf + 2 * D, ALPHA};
      pg8::gemm_phase<pg8::EpiRes<false>, pg8::StaticOrder, PG8_ALIGN, PG8_SP2>(lds, g, S, E); }
    xcd_barrier(xbar);

    {
        LAS float* sg = (LAS float*)lds; LAS float* sb_ = sg + D; LAS float* ssh = sb_ + D; LAS float* ssc = ssh + D;
        if (bx == 0) { const unsigned xb_stride = XBB_STRIDE; for (unsigned i = tid; i < (unsigned)XCD_BAR_WORDS; i += NTHR) *XBW(barB, i) = 0u; }
        for (int rg = bx; rg < M / 128; rg += G) {
            const int b = rg / (SEQ / 128);
            __syncthreads();
            for (int j = tid; j < D; j += NTHR) { sg[j] = ln1_g[j]; sb_[j] = ln1_b[j]; ssh[j] = modf[(size_t)b * NMOD + 3 * D + j]; ssc[j] = modf[(size_t)b * NMOD + 4 * D + j]; }
            __syncthreads();
            for (int i = 0; i < 16; i += 2) { const size_t row0 = (size_t)rg * 128 + wave * 16 + i; f32x4 v[2][4];
#pragma unroll
                for (int r = 0; r < 2; ++r) { const v2u* rr = (const v2u*)(H + (row0 + r) * HW + C_R) + lane;
#pragma unroll
                    for (int j = 0; j < 4; ++j) v[r][j] = bf4_to_f32(rr[64 * j]); }
#pragma unroll
                for (int r = 0; r < 2; ++r) { const size_t row = row0 + r; float rstd; row_stats(v[r], rstd);
                    v2u* x1o = (v2u*)(H + row * HW + C_X1) + lane;
#pragma unroll
                    for (int j = 0; j < 4; ++j) { const int c0 = 4 * lane + 256 * j; v[r][j] = v[r][j] * rstd * *(const LAS f32x4*)(sg + c0) + *(const LAS f32x4*)(sb_ + c0); v2u p; p.x = cvtpk(v[r][j].x, v[r][j].y); p.y = cvtpk(v[r][j].z, v[r][j].w); x1o[64 * j] = p; }
                    row_stats(v[r], rstd);
                    unsigned long long* o8 = (unsigned long long*)(U1 + row * D) + lane;
#pragma unroll
                    for (int j = 0; j < 4; ++j) { const int c0 = 4 * lane + 256 * j; const f32x4 o = v[r][j] * rstd * (*(const LAS f32x4*)(ssc + c0) + 1.0f) + *(const LAS f32x4*)(ssh + c0);
                        o8[64 * j] = (unsigned long long)cvtpk(o.x, o.y) | ((unsigned long long)cvtpk(o.z, o.w) << 32); } } }
        }
    }
    xcd_barrier(xbar);

    const XcdBarrier xbarB = xcd_barrier_post(barB, MISC + 2, XBB_STRIDE);
    { pg8::Gemm g{U1, Wt_ffin, M, 2 * FF, D, D}; pg8::StaticOrder S; S.init(M, 2 * FF, G, bx); pg8::EpiSwiglu E{H + C_ACT, HW};
      pg8::gemm_phase<pg8::EpiSwiglu, pg8::StaticOrder, PG8_ALIGN, PG8_SP2>(lds, g, S, E); }
    xcd_barrier(xbar);

    { pg8::Gemm g{H + C_ACT, Wt_ffout, M, D, FF, HW}; pg8::StaticOrder S; S.init(M, D, G, bx); pg8::EpiRes<true> E{H + C_X1, HW, H + C_R, HW, modf + 5 * D, ALPHA};
      pg8::gemm_phase<pg8::EpiRes<true>, pg8::StaticOrder, PG8_ALIGN, PG8_SP2>(lds, g, S, E); }
    xcd_barrier(xbarB);

    {
        const size_t rstep = (size_t)G * NWAVES;
        for (size_t row0 = (size_t)bx * NWAVES + wave; row0 < (size_t)M; row0 += 4 * rstep) { f32x4 v[4][4];
#pragma unroll
            for (int r = 0; r < 4; ++r) { const size_t row = row0 + r * rstep; if (row < (size_t)M) { const v2u* rr = (const v2u*)(H + row * HW + C_R) + lane;
#pragma unroll
                for (int j = 0; j < 4; ++j) v[r][j] = bf4_to_f32(rr[64 * j]); } }
#pragma unroll
            for (int r = 0; r < 4; ++r) { const size_t row = row0 + r * rstep; if (row < (size_t)M) { float rstd; row_stats(v[r], rstd);
                f32x4* oo = (f32x4*)(args.out + row * D) + lane;
#pragma unroll
                for (int j = 0; j < 4; ++j) { const int c0 = 4 * lane + 256 * j; oo[64 * j] = v[r][j] * rstd * *(const f32x4*)(ln2_g + c0) + *(const f32x4*)(ln2_b + c0); } } }
        }
    }
}

extern "C" void kernel_launch(void* const* d_in, const int* in_sizes, int n_in, void* d_out, int out_size, void* d_ws, size_t ws_size, hipStream_t stream) {
    static int grid = 0;
    if (grid == 0) {
        if (n_in != 15 || out_size != M * D || ws_size < (size_t)M * HW * 2) { fprintf(stderr, "kernel_launch: unexpected problem shape (n_in %d, out %d, ws %zu)\n", n_in, out_size, ws_size); grid = -1; return; }
        int dev = 0, cus = 0, per_cu = 0;
        if (hipGetDevice(&dev) != hipSuccess || hipDeviceGetAttribute(&cus, hipDeviceAttributeMultiprocessorCount, dev) != hipSuccess) { grid = -1; return; }
        if (hipFuncSetAttribute((const void*)fwd_megakernel, hipFuncAttributeMaxDynamicSharedMemorySize, LDS_BYTES) != hipSuccess) { fprintf(stderr, "kernel_launch: hipFuncSetAttribute failed\n"); grid = -1; return; }
        if (hipOccupancyMaxActiveBlocksPerMultiprocessor(&per_cu, (const void*)fwd_megakernel, NTHR, LDS_BYTES) != hipSuccess || per_cu < 1) { fprintf(stderr, "kernel_launch: occupancy query gave %d\n", per_cu); per_cu = 1; }
        (void)hipGetLastError();
        grid = cus * per_cu;
    }
    if (grid < 0) return;
    if (hipMemsetAsync((char*)d_out + DO_BAR, 0, 16384, stream) != hipSuccess) { fprintf(stderr, "kernel_launch: memset failed\n"); return; }
    Args a{};
    for (int i = 0; i < 15; ++i) a.in[i] = (const float*)d_in[i];
    a.out = (float*)d_out; a.ws = (unsigned char*)d_ws;
    void* kargs[] = {&a};
    const hipError_t e = hipLaunchCooperativeKernel((const void*)fwd_megakernel, dim3(grid), dim3(NTHR), kargs, LDS_BYTES, stream);
    if (e != hipSuccess) fprintf(stderr, "kernel_launch: cooperative launch failed: %s (grid %d)\n", hipGetErrorString(e), grid);
}
```

```cpp
#include <hip/hip_runtime.h>
#include <hip/hip_cooperative_groups.h>
#include <cstdio>
#include <cstdint>
namespace cg = cooperative_groups;
namespace pg8 {
#define PG8_LAS __attribute__((address_space(3)))
typedef unsigned short bf16_t;
typedef short bf16x8 __attribute__((ext_vector_type(8)));
typedef float f32x4 __attribute__((ext_vector_type(4)));
typedef unsigned u32x4 __attribute__((ext_vector_type(4)));
constexpr int BM = 256, BK = 64, HALF = 128, HTB = HALF * BK * 2  , STAGE_BYTES = 8 * HTB, NXCD = 8, WGM = 8;

__host__ __device__ __forceinline__ int lds_byte(int r, int c) { const int st = (r >> 4) * 2 + (c >> 5), rr = r & 15, cc = c & 31, ob = rr * 64 + cc * 2; return st * 1024 + (ob ^ (((ob >> 9) & 1) << 5)); }
__host__ __device__ __forceinline__ void stage_rc(int b, int& R, int& C) { const int st = b / 1024, sb = b % 1024, swz = sb ^ (((sb >> 9) & 1) << 5); R = (st >> 1) * 16 + swz / 64; C = (st & 1) * 32 + (swz % 64) / 2; }
__host__ __device__ __forceinline__ int perm32(int rho) { const int n = rho >> 4, i = rho & 15; return 8 * (i >> 2) + 4 * n + (i & 3); }

struct Unit { int pm, pn; };
struct Gemm { const bf16_t* A; const bf16_t* Bt; int M, N, K, lda; };

struct StaticOrder {
    int nM, nN, nwg, G, c;
    __host__ __device__ void init(int M, int N, int G_, int c_) { nM = M / BM; nN = N / BM; nwg = nM * nN; G = G_; c = c_; }
    __host__ __device__ bool next(int i, Unit& u) const {
        const long L = (long)i * G + c; if (L >= nwg) return false;
        int wgid = (int)L; { const int q = nwg / NXCD, r = nwg % NXCD, xcd = wgid % NXCD, off = wgid / NXCD; wgid = (xcd < r ? xcd * (q + 1) : r * (q + 1) + (xcd - r) * q) + off; }
        const int nig = WGM * nN, gid = wgid / nig, fm = gid * WGM, gsz = (nM - fm) < WGM ? (nM - fm) : WGM;
        u.pm = fm + ((wgid % nig) % gsz); u.pn = (wgid % nig) / gsz; return true;
    }
    __device__ __forceinline__ void a_ready(const Unit&) const {}
    __device__ __forceinline__ void done(const Unit&) const {}
};

__device__ __forceinline__ unsigned cvt_pk_bf16(float lo, float hi) { unsigned r; asm volatile("v_cvt_pk_bf16_f32 %0, %1, %2" : "=v"(r) : "v"(lo), "v"(hi)); return r; }
typedef __bf16 bf16x2_t __attribute__((ext_vector_type(2)));
typedef float f32x2_t __attribute__((ext_vector_type(2)));
typedef unsigned u32x2 __attribute__((ext_vector_type(2)));
__device__ __forceinline__ unsigned cvtpk(float lo, float hi) { f32x2_t v = {lo, hi}; bf16x2_t b = __builtin_convertvector(v, bf16x2_t); return __builtin_bit_cast(unsigned, b); }

struct EpiH {
    static constexpr bool PERM = true, AFTER_DRAIN = false;
    bf16_t* H; bf16_t* GA;
    __device__ __forceinline__ void operator()(const f32x4 (&acc)[2][2][4][2], const Unit& u, int wr, int wc, int fr, int fq) const {
        const int row0 = u.pm * BM + wr * 64 + fr;
        if (u.pn < 32) {
            const int col0 = u.pn * BM + wc * 32 + 8 * fq;
#pragma unroll
            for (int ai = 0; ai < 2; ++ai)
#pragma unroll
                for (int m = 0; m < 4; ++m) { bf16_t* rowp = H + (size_t)(row0 + ai * HALF + m * 16) * 8192 + col0;
#pragma unroll
                    for (int bj = 0; bj < 2; ++bj) { const f32x4 v0 = acc[ai][bj][m][0], v1 = acc[ai][bj][m][1];
                        u32x4 w; w.x = cvtpk(v0[0], v0[1]); w.y = cvtpk(v0[2], v0[3]); w.z = cvtpk(v1[0], v1[1]); w.w = cvtpk(v1[2], v1[3]);
                        *(u32x4*)(rowp + bj * HALF) = w; } }
        } else if (wc == 0 && fq < 2) {
#pragma unroll
            for (int ai = 0; ai < 2; ++ai)
#pragma unroll
                for (int m = 0; m < 4; ++m) { const f32x4 v0 = acc[ai][0][m][0], v1 = acc[ai][0][m][1];
                    u32x4 w; w.x = cvtpk(v0[0], v0[1]); w.y = cvtpk(v0[2], v0[3]); w.z = cvtpk(v1[0], v1[1]); w.w = cvtpk(v1[2], v1[3]);
                    *(u32x4*)(GA + (size_t)(row0 + ai * HALF + m * 16) * 16 + 8 * fq) = w; }
        }
    }
};
template <bool XBF> struct EpiRes {
    static constexpr bool PERM = true, AFTER_DRAIN = false;
    const void* X; int ldx; bf16_t* O; int ldo; const float* gate; float alpha;
    __device__ __forceinline__ void operator()(const f32x4 (&acc)[2][2][4][2], const Unit& u, int wr, int wc, int fr, int fq) const {
        const int b = u.pm >> 4; const int col0 = u.pn * BM + wc * 32 + 8 * fq;
#pragma unroll
        for (int bj = 0; bj < 2; ++bj) { const int c = col0 + bj * HALF;
            const f32x4 g0 = *(const f32x4*)(gate + (size_t)b * 6144 + c) + 1.0f, g1 = *(const f32x4*)(gate + (size_t)b * 6144 + c + 4) + 1.0f;
#pragma unroll
            for (int ai = 0; ai < 2; ++ai)
#pragma unroll
                for (int m = 0; m < 4; ++m) { const size_t r = (size_t)(u.pm * BM + ai * HALF + wr * 64 + m * 16 + fr); f32x4 x0, x1;
                    if (XBF) { const u32x4 xv = *(const u32x4*)((const bf16_t*)X + r * ldx + c);
                        x0 = (f32x4){__uint_as_float(xv.x << 16), __uint_as_float(xv.x & 0xffff0000u), __uint_as_float(xv.y << 16), __uint_as_float(xv.y & 0xffff0000u)};
                        x1 = (f32x4){__uint_as_float(xv.z << 16), __uint_as_float(xv.z & 0xffff0000u), __uint_as_float(xv.w << 16), __uint_as_float(xv.w & 0xffff0000u)}; }
                    else { const float* xp = (const float*)X + r * ldx + c; x0 = *(const f32x4*)xp; x1 = *(const f32x4*)(xp + 4); }
                    const f32x4 o0 = x0 * alpha + g0 * acc[ai][bj][m][0], o1 = x1 * alpha + g1 * acc[ai][bj][m][1];
                    u32x4 w; w.x = cvtpk(o0[0], o0[1]); w.y = cvtpk(o0[2], o0[3]); w.z = cvtpk(o1[0], o1[1]); w.w = cvtpk(o1[2], o1[3]);
                    *(u32x4*)(O + r * ldo + c) = w; } }
    }
};
struct EpiSwiglu {
    static constexpr bool PERM = true, AFTER_DRAIN = false;
    bf16_t* O; int ldo;
    __device__ __forceinline__ void operator()(const f32x4 (&acc)[2][2][4][2], const Unit& u, int wr, int wc, int fr, int fq) const {
        const int row0 = u.pm * BM + wr * 64 + fr; const int col0 = u.pn * HALF + wc * 32 + 8 * fq;
#pragma unroll
        for (int ai = 0; ai < 2; ++ai)
#pragma unroll
            for (int m = 0; m < 4; ++m) { float a[8];
#pragma unroll
                for (int n = 0; n < 2; ++n)
#pragma unroll
                    for (int j = 0; j < 4; ++j) { const float g = acc[ai][0][m][n][j], up = acc[ai][1][m][n][j]; a[4 * n + j] = g * __builtin_amdgcn_rcpf(1.0f + __builtin_amdgcn_exp2f(-g * 1.4426950408889634f)) * up; }
                u32x4 w; w.x = cvtpk(a[0], a[1]); w.y = cvtpk(a[2], a[3]); w.z = cvtpk(a[4], a[5]); w.w = cvtpk(a[6], a[7]);
                *(u32x4*)(O + (size_t)(row0 + ai * HALF + m * 16) * ldo + col0) = w; }
    }
};

template <class Epi, class Sched, bool ALIGN_EPI = false, bool SP2 = false>
__device__ __forceinline__ void gemm_phase(PG8_LAS unsigned char* lds, const Gemm g, const Sched& S, const Epi& E) {
    int tid_ = threadIdx.x; asm volatile("" : "+v"(tid_));
    const int tid = tid_, wid = __builtin_amdgcn_readfirstlane(tid >> 6), lane = tid & 63, wr = wid >> 2, wc = wid & 3, fr = lane & 15, fq = lane >> 4;
    const int K = g.K, nt = K / BK;
    unsigned voffA[2], voffB[2];
#pragma unroll
    for (int i = 0; i < 2; ++i) { int R, C; stage_rc(tid * 16 + i * 8192, R, C); const int Rb = Epi::PERM ? ((R & ~31) + perm32(R & 31)) : R;
        voffA[i] = (unsigned)(R * g.lda + C) * 2u; voffB[i] = (unsigned)(Rb * K + C) * 2u; }
    const size_t kstep = (size_t)(BK * 2);
    const size_t hstepA = (size_t)HALF * g.lda * 2, hstepB = (size_t)HALF * K * 2;
    const size_t tstepA = 2 * hstepA, tstepB = 2 * hstepB;
    const unsigned ldsw = (unsigned)wid * 1024u;
    const int aoff = lds_byte(wr * 64 + fr, fq * 8), boff = lds_byte(wc * 32 + fr, fq * 8);
#define PG8_SA(b, h) (((b) * 2 + (h)) * HTB)
#define PG8_SB(b, h) ((4 + (b) * 2 + (h)) * HTB)
#define PG8_STAGE(bufoff, gbase, voff) do { _Pragma("unroll") for (int _i = 0; _i < 2; ++_i) \
        __builtin_amdgcn_global_load_lds((const unsigned*)((const char*)(gbase) + (voff)[_i]), (PG8_LAS unsigned*)(lds + (bufoff) + ldsw + _i * 8192), 16, 0, 0); } while (0)
#define PG8_LDA(dst, b, h) do { _Pragma("unroll") for (int m = 0; m < 4; ++m) _Pragma("unroll") for (int k = 0; k < 2; ++k) dst[m][k] = *(const PG8_LAS bf16x8*)(lds + PG8_SA(b, h) + aoff + m * 2048 + k * 1024); } while (0)
#define PG8_LDB(dst, b, h) do { _Pragma("unroll") for (int n = 0; n < 2; ++n) _Pragma("unroll") for (int k = 0; k < 2; ++k) dst[n][k] = *(const PG8_LAS bf16x8*)(lds + PG8_SB(b, h) + boff + n * 2048 + k * 1024); } while (0)
#define PG8_MMA(ai, bj, At, Bt) do { __builtin_amdgcn_s_setprio(1); _Pragma("unroll") for (int m = 0; m < 4; ++m) _Pragma("unroll") for (int n = 0; n < 2; ++n) _Pragma("unroll") for (int k = 0; k < 2; ++k) \
        acc[ai][bj][m][n] = __builtin_amdgcn_mfma_f32_16x16x32_bf16(Bt[n][k], At[m][k], acc[ai][bj][m][n], 0, 0, 0); __builtin_amdgcn_s_setprio(0); } while (0)
#define PG8_WAIT_V(n) asm volatile("s_waitcnt vmcnt(" #n ")" ::: "memory")
#define PG8_WAIT_L(n) asm volatile("s_waitcnt lgkmcnt(" #n ")" ::: "memory")
#define PG8_BAR __builtin_amdgcn_s_barrier()
#define PG8_SCHED __builtin_amdgcn_sched_barrier(0)
    Unit cur, nxt; int ui = 0;
    if (!S.next(0, cur)) return;
    f32x4 acc[2][2][4][2];
#pragma unroll
    for (int a = 0; a < 2; ++a)
#pragma unroll
        for (int b = 0; b < 2; ++b)
#pragma unroll
            for (int m = 0; m < 4; ++m)
#pragma unroll
                for (int n = 0; n < 2; ++n) acc[a][b][m][n] = (f32x4){0.f, 0.f, 0.f, 0.f};
    bf16x8 At[4][2], B0[2][2], B1[2][2];
    const char* cA = (const char*)g.A + (size_t)cur.pm * tstepA; const char* cB = (const char*)g.Bt + (size_t)cur.pn * tstepB;
    S.a_ready(cur);
    if constexpr (SP2) {
        PG8_STAGE(PG8_SB(0, 0), cB, voffB); PG8_STAGE(PG8_SB(0, 1), cB + hstepB, voffB); PG8_STAGE(PG8_SA(0, 0), cA, voffA); PG8_STAGE(PG8_SA(0, 1), cA + hstepA, voffA);
        if (wr == 1) PG8_BAR;
        PG8_WAIT_V(2); PG8_BAR;
        PG8_STAGE(PG8_SB(1, 0), cB + kstep, voffB); PG8_STAGE(PG8_SA(1, 0), cA + kstep, voffA); PG8_STAGE(PG8_SB(1, 1), cB + hstepB + kstep, voffB);
        PG8_WAIT_V(6); PG8_BAR;
    } else {
        PG8_STAGE(PG8_SB(0, 0), cB, voffB); PG8_STAGE(PG8_SA(0, 0), cA, voffA); PG8_STAGE(PG8_SB(0, 1), cB + hstepB, voffB); PG8_STAGE(PG8_SA(0, 1), cA + hstepA, voffA);
        if (wr == 1) PG8_BAR;
        PG8_WAIT_V(4); PG8_BAR;
        PG8_STAGE(PG8_SB(1, 0), cB + kstep, voffB); PG8_STAGE(PG8_SA(1, 0), cA + kstep, voffA); PG8_STAGE(PG8_SB(1, 1), cB + hstepB + kstep, voffB);
        PG8_WAIT_V(6); PG8_BAR;
    }
    for (;;) {
        const bool has_next = S.next(ui + 1, nxt);
        const char* nA = has_next ? (const char*)g.A + (size_t)nxt.pm * tstepA : cA; const char* nB = has_next ? (const char*)g.Bt + (size_t)nxt.pn * tstepB : cB;
        for (int t = 0; t < nt; t += 2) {
            const bool last = (t == nt - 2);
            const char* a1 = cA + (size_t)(t + 1) * kstep;
            const char* a2 = last ? nA : cA + (size_t)(t + 2) * kstep; const char* b2 = last ? nB : cB + (size_t)(t + 2) * kstep;
            const char* a3 = a2 + kstep; const char* b3 = b2 + kstep;
            if (last && has_next) S.a_ready(nxt);
            if constexpr (SP2) {
            PG8_LDB(B0, 0, 0); PG8_LDB(B1, 0, 1); PG8_SCHED; PG8_LDA(At, 0, 0); PG8_STAGE(PG8_SA(1, 1), a1 + hstepA, voffA);
            PG8_WAIT_V(8); PG8_WAIT_L(0); PG8_BAR; PG8_MMA(0, 0, At, B0); PG8_MMA(0, 1, At, B1); PG8_BAR; PG8_SCHED;
            PG8_LDA(At, 0, 1); PG8_STAGE(PG8_SB(0, 0), b2, voffB); PG8_STAGE(PG8_SB(0, 1), b2 + hstepB, voffB); PG8_STAGE(PG8_SA(0, 0), a2, voffA);
            PG8_WAIT_V(8); PG8_WAIT_L(0); PG8_BAR; PG8_MMA(1, 0, At, B0); PG8_MMA(1, 1, At, B1); PG8_BAR; PG8_SCHED;
            PG8_LDB(B0, 1, 0); PG8_LDB(B1, 1, 1); PG8_SCHED; PG8_LDA(At, 1, 0); PG8_STAGE(PG8_SA(0, 1), a2 + hstepA, voffA);
            PG8_WAIT_V(8); PG8_WAIT_L(0); PG8_BAR; PG8_MMA(0, 0, At, B0); PG8_MMA(0, 1, At, B1); PG8_BAR; PG8_SCHED;
            PG8_LDA(At, 1, 1); PG8_STAGE(PG8_SB(1, 0), b3, voffB); PG8_STAGE(PG8_SB(1, 1), b3 + hstepB, voffB); PG8_STAGE(PG8_SA(1, 0), a3, voffA);
            PG8_WAIT_V(8); PG8_WAIT_L(0); PG8_BAR; PG8_MMA(1, 0, At, B0); PG8_MMA(1, 1, At, B1); PG8_BAR; PG8_SCHED;
            } else {
            PG8_LDB(B0, 0, 0); PG8_SCHED; PG8_LDA(At, 0, 0); PG8_STAGE(PG8_SA(1, 1), a1 + hstepA, voffA);
            PG8_WAIT_L(8); PG8_BAR; PG8_WAIT_L(0); PG8_MMA(0, 0, At, B0); PG8_BAR; PG8_SCHED;
            PG8_LDB(B1, 0, 1); PG8_STAGE(PG8_SB(0, 0), b2, voffB);
            PG8_BAR; PG8_WAIT_L(0); PG8_MMA(0, 1, At, B1); PG8_BAR;
            PG8_LDA(At, 0, 1); PG8_STAGE(PG8_SA(0, 0), a2, voffA);
            PG8_BAR; PG8_WAIT_L(0); PG8_MMA(1, 0, At, B0); PG8_BAR; PG8_SCHED;
            PG8_STAGE(PG8_SB(0, 1), b2 + hstepB, voffB);
            PG8_WAIT_V(6); PG8_BAR; PG8_MMA(1, 1, At, B1); PG8_BAR;
            PG8_LDB(B0, 1, 0); PG8_SCHED; PG8_LDA(At, 1, 0); PG8_STAGE(PG8_SA(0, 1), a2 + hstepA, voffA);
            PG8_WAIT_L(8); PG8_BAR; PG8_WAIT_L(0); PG8_MMA(0, 0, At, B0); PG8_BAR; PG8_SCHED;
            PG8_LDB(B1, 1, 1); PG8_STAGE(PG8_SB(1, 0), b3, voffB);
            PG8_BAR; PG8_WAIT_L(0); PG8_MMA(0, 1, At, B1); PG8_BAR;
            PG8_LDA(At, 1, 1); PG8_STAGE(PG8_SA(1, 0), a3, voffA);
            PG8_BAR; PG8_WAIT_L(0); PG8_MMA(1, 0, At, B0); PG8_BAR; PG8_SCHED;
            PG8_STAGE(PG8_SB(1, 1), b3 + hstepB, voffB);
            PG8_WAIT_V(6); PG8_BAR; PG8_MMA(1, 1, At, B1); PG8_BAR;
            }
        }
        if constexpr (ALIGN_EPI) { if (wr == 0) PG8_BAR; }
        if constexpr (!Epi::AFTER_DRAIN) { E(acc, cur, wr, wc, fr, fq); S.done(cur); }
        if (!has_next) break;
#pragma unroll
        for (int a = 0; a < 2; ++a)
#pragma unroll
            for (int b = 0; b < 2; ++b)
#pragma unroll
                for (int m = 0; m < 4; ++m)
#pragma unroll
                    for (int n = 0; n < 2; ++n) acc[a][b][m][n] = (f32x4){0.f, 0.f, 0.f, 0.f};
        cur = nxt; cA = nA; cB = nB; ++ui;
        if constexpr (ALIGN_EPI) { if (wr == 1) PG8_BAR; }
    }
    PG8_WAIT_V(0);
    if constexpr (!ALIGN_EPI) { if (wr == 0) PG8_BAR; }
    PG8_BAR;
    if constexpr (Epi::AFTER_DRAIN) { E.fused(acc, cur, wr, wc, fr, fq, lds, wid, lane); S.done(cur); }
#undef PG8_SA
#undef PG8_SB
#undef PG8_STAGE
#undef PG8_LDA
#undef PG8_LDB
#undef PG8_MMA
#undef PG8_WAIT_V
#undef PG8_WAIT_L
#undef PG8_BAR
#undef PG8_SCHED
}
}
#ifndef PG8_SP2
#define PG8_SP2 true
#endif
#ifndef PG8_ALIGN
#define PG8_ALIGN true
#endif
#define LAS __attribute__((address_space(3)))
typedef unsigned short bf16;
typedef short bf16x8 __attribute__((ext_vector_type(8)));
typedef short s16x4 __attribute__((ext_vector_type(4)));
typedef float f32x4 __attribute__((ext_vector_type(4)));
typedef float f32x16 __attribute__((ext_vector_type(16)));
typedef unsigned v4u __attribute__((ext_vector_type(4)));
typedef unsigned v2u __attribute__((ext_vector_type(2)));
using pg8::cvtpk;
constexpr int NWAVES = 8, NTHR = 512;
constexpr int BATCH = 8, SEQ = 4096, D = 1024, M = BATCH * SEQ, FF = 2816, NMOD = 6 * D;
constexpr int HW = 8192;
constexpr int C_GQ = 0, C_GK = 512, C_GV = 1024, C_GG = 2048, C_SQ = 3072, C_SK = 4096, C_SV = 5120, C_MA = 6144, C_MB = 7168;
constexpr int NIN = 8448;
constexpr int C_U2 = 0, C_ACT = 1024;
constexpr int C_R = 4096, C_X1 = 6144;
constexpr float LN_EPS = 1e-5f, ALPHA = 1.189207115002721f;
constexpr float QK_SCALE = 0.08838834764831845f;
constexpr size_t MiB = 1u << 20;
constexpr size_t DO_U1 = 0, DO_WIN = 64 * MiB, DO_WOUT = 81 * MiB, DO_WFFIN = 85 * MiB, DO_WFFOUT = 96 * MiB, DO_GA = 102 * MiB, DO_MODP = 103 * MiB, DO_MODF = 106 * MiB;
static_assert(DO_WIN + (size_t)NIN * D * 2 <= DO_WOUT && DO_WOUT + (size_t)D * 2048 * 2 <= DO_WFFIN && DO_WFFIN + (size_t)2 * FF * D * 2 <= DO_WFFOUT && DO_WFFOUT + (size_t)D * FF * 2 <= DO_GA &&
              DO_GA + (size_t)M * 16 * 2 <= DO_MODP && DO_MODP + (size_t)16 * BATCH * NMOD * 4 <= DO_MODF && DO_MODF + (size_t)BATCH * NMOD * 4 <= 128 * MiB, "d_out scratch map");
constexpr int LDS_BYTES = 147456;

__device__ __forceinline__ float bf2f(unsigned short u) { return __uint_as_float((unsigned)u << 16); }
__device__ __forceinline__ f32x4 bf4_to_f32(v2u p) { return (f32x4){__uint_as_float(p.x << 16), __uint_as_float(p.x & 0xffff0000u), __uint_as_float(p.y << 16), __uint_as_float(p.y & 0xffff0000u)}; }
__device__ __forceinline__ float wave_sum(float v) {
#pragma unroll
    for (int o = 1; o < 64; o <<= 1) v += __shfl_xor(v, o);
    return v;
}
__device__ __forceinline__ int crow(int reg, int h) { return (reg & 3) + 8 * (reg >> 2) + 4 * h; }
#define MFMA32(a, b, c) __builtin_amdgcn_mfma_f32_32x32x16_bf16((a), (b), (c), 0, 0, 0)
__device__ __forceinline__ bf16x8 pack8(float a0, float a1, float a2, float a3, float a4, float a5, float a6, float a7) {
    v4u p; p.x = cvtpk(a0, a1); p.y = cvtpk(a2, a3); p.z = cvtpk(a4, a5); p.w = cvtpk(a6, a7); return __builtin_bit_cast(bf16x8, p);
}
#define PACK_STEP(x, s) pack8((x)[8 * (s)], (x)[8 * (s) + 1], (x)[8 * (s) + 2], (x)[8 * (s) + 3], (x)[8 * (s) + 4], (x)[8 * (s) + 5], (x)[8 * (s) + 6], (x)[8 * (s) + 7])
typedef short v4i16_t __attribute__((ext_vector_type(4)));
__device__ __forceinline__ s16x4 trd(const LAS unsigned char* p) { return __builtin_bit_cast(s16x4, __builtin_amdgcn_ds_read_tr16_b64_v4i16((LAS v4i16_t*)p)); }
__device__ __forceinline__ bf16x8 trfrag(const LAS unsigned char* p, int stride8) { const s16x4 lo = trd(p), hi = trd(p + stride8); return __builtin_shufflevector(lo, hi, 0, 1, 2, 3, 4, 5, 6, 7); }
constexpr float LOG2E = 1.4426950408889634f;
__device__ __forceinline__ float ex2(float x) { return __builtin_amdgcn_exp2f(x); }
__device__ __forceinline__ float lg2(float x) { return __builtin_amdgcn_logf(x); }
__device__ __forceinline__ float sigmoidf_(float x) { return __builtin_amdgcn_rcpf(1.0f + ex2(-x * LOG2E)); }
__device__ __forceinline__ float softplus2(float z2) { return fmaxf(z2, 0.f) + lg2(1.0f + ex2(-fabsf(z2))); }

__device__ __forceinline__ int tr_srccol(int d, int map) {
    if (map == 0) return d < 3072 ? d : (d < 8192 ? d + 16 : (d < 8208 ? 3072 + (d - 8192) : -1));
    if (map == 1) { const int pn = d >> 8, j = d & 255; return j < 128 ? 128 * pn + j : FF + 128 * pn + (j - 128); }
    return d;
}
__device__ __forceinline__ void transpose_item(const float* W, int Nsrc, bf16* WT, int ldw, int d0, int k0, int map, bool dup, LAS float* scr, int lane) {
    const int cgp = lane & 7, kr = lane >> 3; const int sc = tr_srccol(d0 + 4 * cgp, map);
#pragma unroll
    for (int i = 0; i < 8; ++i) { const int kk = kr + 8 * i; const f32x4 v = sc >= 0 ? *(const f32x4*)(W + (size_t)(k0 + kk) * Nsrc + sc) : (f32x4){0.f, 0.f, 0.f, 0.f};
        LAS float* p = scr + kk * 33 + 4 * cgp; p[0] = v.x; p[1] = v.y; p[2] = v.z; p[3] = v.w; }
    asm volatile("s_waitcnt lgkmcnt(0)" ::: "memory");
    const int c = lane & 7;
#pragma unroll
    for (int j = 0; j < 4; ++j) { const int n = (lane >> 3) + 8 * j; const LAS float* s = scr + (8 * c) * 33 + n;
        v4u o; o.x = cvtpk(s[0 * 33], s[1 * 33]); o.y = cvtpk(s[2 * 33], s[3 * 33]); o.z = cvtpk(s[4 * 33], s[5 * 33]); o.w = cvtpk(s[6 * 33], s[7 * 33]);
        bf16* dst = WT + (size_t)(d0 + n) * ldw + k0 + 8 * c; *(v4u*)dst = o; if (dup) *(v4u*)(dst + 1024) = o; }
    asm volatile("s_waitcnt lgkmcnt(0)" ::: "memory");
}

struct Args { const float* in[15]; float* out; unsigned char* ws; };

__device__ __forceinline__ void row_stats(f32x4 (&v)[4], float& rstd) {
    float s = 0.f;
#pragma unroll
    for (int j = 0; j < 4; ++j) s += (v[j].x + v[j].y) + (v[j].z + v[j].w);
    const float mean = wave_sum(s) * (1.f / D); float s2 = 0.f;
#pragma unroll
    for (int j = 0; j < 4; ++j) { v[j] = v[j] - mean; s2 += (v[j].x * v[j].x + v[j].y * v[j].y) + (v[j].z * v[j].z + v[j].w * v[j].w); }
    rstd = 1.0f / sqrtf(wave_sum(s2) * (1.f / D) + LN_EPS);
}

constexpr int SB_KS = 272;
__device__ __forceinline__ void sb_unit(bf16* H, LAS unsigned char* wl, int b, int hd, int qt, int lane) {
    const int n = lane & 31, hh = lane >> 5, i16 = lane & 15, tq = i16 >> 2, tp = i16 & 3, blk = (lane >> 4) & 1;
    const size_t rowbase = (size_t)b * SEQ;
    bf16x8 qf[8];
    { const bf16* qp = H + (rowbase + 32 * qt + n) * HW + C_SQ + hd * 128 + 8 * hh;
#pragma unroll
      for (int s = 0; s < 8; ++s) qf[s] = *(const bf16x8*)(qp + 16 * s); }
    f32x16 oT[4];
#pragma unroll
    for (int cb = 0; cb < 4; ++cb)
#pragma unroll
        for (int r = 0; r < 16; ++r) oT[cb][r] = 0.f;
    float R = 0.f;
    LAS unsigned char* Kl = wl; LAS unsigned char* Vl = wl + 32 * SB_KS;
    const LAS unsigned char* kread = Kl + n * SB_KS + 16 * hh;
    const LAS unsigned char* vread = Vl + (4 * hh + tq) * SB_KS + (16 * blk + 4 * tp) * 2;
    v4u kreg[8], vreg[8];
    { const bf16* kp = H + (rowbase + 32 * qt) * HW + C_SK + hd * 128; const bf16* vp = kp + (C_SV - C_SK);
#pragma unroll
      for (int i = 0; i < 8; ++i) { const int id = lane + 64 * i, row = id >> 4, ch = id & 15; kreg[i] = *(const v4u*)(kp + (size_t)row * HW + ch * 8); vreg[i] = *(const v4u*)(vp + (size_t)row * HW + ch * 8); } }
    for (int kt = qt; kt >= 0; --kt) {
#pragma unroll
        for (int i = 0; i < 8; ++i) { const int id = lane + 64 * i, row = id >> 4, ch = id & 15;
            *(LAS v4u*)(Kl + row * SB_KS + ch * 16) = kreg[i]; *(LAS v4u*)(Vl + row * SB_KS + ch * 16) = vreg[i]; }
        if (kt > 0) { const bf16* kp = H + (rowbase + 32 * (kt - 1)) * HW + C_SK + hd * 128; const bf16* vp = kp + (C_SV - C_SK);
#pragma unroll
            for (int i = 0; i < 8; ++i) { const int id = lane + 64 * i, row = id >> 4, ch = id & 15; kreg[i] = *(const v4u*)(kp + (size_t)row * HW + ch * 8); vreg[i] = *(const v4u*)(vp + (size_t)row * HW + ch * 8); } }
        f32x16 st, st1;
#pragma unroll
        for (int r = 0; r < 16; ++r) { st[r] = 0.f; st1[r] = 0.f; }
#pragma unroll
        for (int s = 0; s < 8; s += 2) { const bf16x8 kf = *(const LAS bf16x8*)(kread + 32 * s), kf1 = *(const LAS bf16x8*)(kread + 32 * s + 32); st = MFMA32(kf, qf[s], st); st1 = MFMA32(kf1, qf[s + 1], st1); }
#pragma unroll
        for (int r = 0; r < 16; ++r) st[r] += st1[r];
        const bool diag = (kt == qt);
        float sp[16], w[16];
#pragma unroll
        for (int r = 0; r < 16; ++r) { const float z = st[r] * (QK_SCALE * LOG2E); const float spv = softplus2(z); const bool valid = !diag || (crow(r, hh) < n);
            sp[r] = valid ? spv : 0.f; w[r] = valid ? (z - spv) : -1.0e30f; }
        float own[4], par[4];
#pragma unroll
        for (int g = 0; g < 4; ++g) own[g] = (sp[4 * g] + sp[4 * g + 1]) + (sp[4 * g + 2] + sp[4 * g + 3]);
#pragma unroll
        for (int g = 0; g < 4; ++g) par[g] = __shfl_xor(own[g], 32);
        float U[4];
        U[3] = 0.f; U[2] = own[3] + par[3]; U[1] = U[2] + (own[2] + par[2]); U[0] = U[1] + (own[1] + par[1]);
        const float total = U[0] + (own[0] + par[0]);
#pragma unroll
        for (int g = 0; g < 4; ++g) { float after = R + U[g] + (hh == 0 ? par[g] : 0.f);
            w[4 * g + 3] = ex2(w[4 * g + 3] - after); after += sp[4 * g + 3];
            w[4 * g + 2] = ex2(w[4 * g + 2] - after); after += sp[4 * g + 2];
            w[4 * g + 1] = ex2(w[4 * g + 1] - after); after += sp[4 * g + 1];
            w[4 * g] = ex2(w[4 * g] - after); }
        R += total;
        const bf16x8 wf0 = pack8(w[0], w[1], w[2], w[3], w[4], w[5], w[6], w[7]), wf1 = pack8(w[8], w[9], w[10], w[11], w[12], w[13], w[14], w[15]);
#pragma unroll
        for (int cb = 0; cb < 4; ++cb) {
            const bf16x8 v0 = trfrag(vread + 64 * cb, 8 * SB_KS), v1 = trfrag(vread + 16 * SB_KS + 64 * cb, 8 * SB_KS);
            oT[cb] = MFMA32(v0, wf0, oT[cb]); oT[cb] = MFMA32(v1, wf1, oT[cb]); }
        asm volatile("s_waitcnt lgkmcnt(0)" ::: "memory");
        if (__ballot(R <= 150.1f) == 0ull) break;
    }
    const size_t mrow = (rowbase + 32 * qt + n) * HW;
#pragma unroll
    for (int cb = 0; cb < 4; ++cb)
#pragma unroll
        for (int g = 0; g < 4; ++g) { const int dh0 = hd * 128 + 32 * cb + 8 * g + 4 * hh;
            const v2u mb = *(const v2u*)(H + mrow + C_MB + dh0);
            const float g0 = sigmoidf_(__uint_as_float(mb.x << 16)), g1 = sigmoidf_(__uint_as_float(mb.x & 0xffff0000u)), g2 = sigmoidf_(__uint_as_float(mb.y << 16)), g3 = sigmoidf_(__uint_as_float(mb.y & 0xffff0000u));
            v2u o; o.x = cvtpk(oT[cb][4 * g] * g0, oT[cb][4 * g + 1] * g1); o.y = cvtpk(oT[cb][4 * g + 2] * g2, oT[cb][4 * g + 3] * g3);
            *(v2u*)(H + mrow + C_SQ + dh0) = o; }
}
constexpr int GL_QS = 272, GL_VS = 528;
constexpr int GL_QE = 0, GL_KE = 64 * GL_QS, GL_KD = 2 * 64 * GL_QS, GL_VV = 3 * 64 * GL_QS, GL_GA = GL_VV + 64 * GL_VS, GL_SEG = GL_GA + 4096, GL_EB = GL_SEG + 2048, GL_SSQ = GL_EB + 512, GL_WUP = GL_SSQ + 2048, GL_END = GL_WUP + 8192;
static_assert(GL_END <= 131072, "GLA LDS map");
constexpr int GL_NSEG = 8, GL_SEGCH = (SEQ / 64) / GL_NSEG, GL_STATE = 8 * 4 * 16 * 64;
template <bool FULL>
__device__ __forceinline__ void gla_seg(bf16* H, const bf16* GA, const float* w_up, const float* b_alpha, const float* gng, float* Lst, float* Lsum, LAS unsigned char* lds, int unit, int tid) {
    const int b = unit >> 5, hg = (unit >> 3) & 3, sj = unit & 7;
    const int lane = tid & 63, wave = tid >> 6, n = lane & 31, hh = lane >> 5, i16 = lane & 15, tq = i16 >> 2, tp = i16 & 3, blk = (lane >> 4) & 1;
    const int d = tid & 127, seg = tid >> 7;
    LAS float* WUP = (LAS float*)(lds + GL_WUP);
#pragma unroll
    for (int r = 0; r < 4; ++r) WUP[(4 * seg + r) * 128 + d] = w_up[(4 * seg + r) * 512 + hg * 128 + d];
    f32x16 sacc[4];
#pragma unroll
    for (int db = 0; db < 4; ++db)
#pragma unroll
        for (int r = 0; r < 16; ++r) sacc[db][r] = 0.f;
    LAS float* GAc = (LAS float*)(lds + GL_GA); LAS float* SEG = (LAS float*)(lds + GL_SEG); LAS float* EB = (LAS float*)(lds + GL_EB); LAS float* SSQ = (LAS float*)(lds + GL_SSQ);
    const LAS unsigned char* vtr_base = lds + GL_VV + (4 * hh + tq) * GL_VS + (32 * wave + 16 * blk + 4 * tp) * 2;
    const LAS unsigned char* kdtr_base = lds + GL_KD + (4 * hh + tq) * GL_QS + (16 * blk + 4 * tp) * 2;
    float lsum = 0.f;
    if (FULL && sj > 0) {
        LAS float* EBA = SEG;
        __syncthreads();
        for (int e = tid; e < sj * 128; e += NTHR) EBA[e] = ex2(Lsum[(unit - sj) * 128 + e]);
        __syncthreads();
        for (int jp = 0; jp < sj; ++jp) { const float* Lp = Lst + (size_t)(unit - sj + jp) * GL_STATE + (size_t)wave * 4 * 16 * 64 + lane;
#pragma unroll
            for (int db = 0; db < 4; ++db)
#pragma unroll
                for (int g = 0; g < 4; ++g) { const f32x4 e4 = *(const LAS f32x4*)(EBA + jp * 128 + 32 * db + 8 * g + 4 * hh);
#pragma unroll
                    for (int j = 0; j < 4; ++j) sacc[db][4 * g + j] = sacc[db][4 * g + j] * e4[j] + Lp[(db * 16 + 4 * g + j) * 64]; } }
        __syncthreads();
    }
    v4u qpre[2], kpre[2], vpre[4]; unsigned gapre;
#define GLA_FETCH(cc) do { const size_t mm = (size_t)b * SEQ + 64 * (size_t)(cc); \
        _Pragma("unroll") for (int i = 0; i < 2; ++i) { const int id = tid + NTHR * i, row = id >> 4, ch = id & 15; const bf16* rp = H + (mm + row) * HW + hg * 128 + ch * 8; \
            if (FULL) qpre[i] = *(const v4u*)(rp + C_GQ); kpre[i] = *(const v4u*)(rp + C_GK); } \
        _Pragma("unroll") for (int i = 0; i < 4; ++i) { const int id = tid + NTHR * i, row = id >> 5, ch = id & 31; vpre[i] = *(const v4u*)(H + (mm + row) * HW + C_GV + hg * 256 + ch * 8); } \
        gapre = *(const unsigned*)(GA + mm * 16 + 2 * tid); } while (0)
    GLA_FETCH(sj * GL_SEGCH);
    for (int c = sj * GL_SEGCH; c < (sj + 1) * GL_SEGCH; ++c) {
        const size_t m0 = (size_t)b * SEQ + 64 * c;
#pragma unroll
        for (int i = 0; i < 2; ++i) { const int id = tid + NTHR * i, row = id >> 4, ch = id & 15;
            if (FULL) *(LAS v4u*)(lds + GL_QE + row * GL_QS + ch * 16) = qpre[i];
            *(LAS v4u*)(lds + GL_KE + row * GL_QS + ch * 16) = kpre[i]; }
#pragma unroll
        for (int i = 0; i < 4; ++i) { const int id = tid + NTHR * i, row = id >> 5, ch = id & 31; *(LAS v4u*)(lds + GL_VV + row * GL_VS + ch * 16) = vpre[i]; }
        GAc[2 * tid] = __uint_as_float(gapre << 16); GAc[2 * tid + 1] = __uint_as_float(gapre & 0xffff0000u);
        __syncthreads();
        float bb[16]; float run = 0.f; float wup[16]; const float bal = b_alpha[hg * 128 + d];
#pragma unroll
        for (int r = 0; r < 16; ++r) wup[r] = WUP[r * 128 + d];
#pragma unroll
        for (int ii = 0; ii < 16; ++ii) { const LAS f32x4* g4 = (const LAS f32x4*)(GAc + (16 * seg + ii) * 16); float z = bal;
#pragma unroll
            for (int r4 = 0; r4 < 4; ++r4) { const f32x4 gv = g4[r4]; z += gv.x * wup[4 * r4] + gv.y * wup[4 * r4 + 1] + gv.z * wup[4 * r4 + 2] + gv.w * wup[4 * r4 + 3]; }
            run += -softplus2(-z * LOG2E) * (1.0f / 16.0f); bb[ii] = run; }
        SEG[seg * 128 + d] = run;
        __syncthreads();
        { const float t0 = SEG[d], t1 = SEG[128 + d], t2 = SEG[256 + d], t3 = SEG[384 + d];
          const float off = (seg > 0 ? t0 : 0.f) + (seg > 1 ? t1 : 0.f) + (seg > 2 ? t2 : 0.f); const float blast = ((t0 + t1) + t2) + t3;
          if (seg == 0) { EB[d] = ex2(blast); lsum += blast; }
#pragma unroll
          for (int ii = 0; ii < 16; ++ii) { const int i = 16 * seg + ii; const float bi = bb[ii] + off; const float qv = FULL ? bf2f(*(const LAS unsigned short*)(lds + GL_QE + i * GL_QS + d * 2)) : 0.f, kv = bf2f(*(const LAS unsigned short*)(lds + GL_KE + i * GL_QS + d * 2));
              if (FULL) { *(LAS unsigned short*)(lds + GL_QE + i * GL_QS + d * 2) = (unsigned short)(cvtpk(qv * QK_SCALE * ex2(bi), 0.f) & 0xffffu);
                          *(LAS unsigned short*)(lds + GL_KE + i * GL_QS + d * 2) = (unsigned short)(cvtpk(kv * ex2(-bi), 0.f) & 0xffffu); }
              *(LAS unsigned short*)(lds + GL_KD + i * GL_QS + d * 2) = (unsigned short)(cvtpk(kv * ex2(blast - bi), 0.f) & 0xffffu); } }
        __syncthreads();
        if (c + 1 < (sj + 1) * GL_SEGCH) GLA_FETCH(c + 1);
        f32x16 oT[2];
#pragma unroll
        for (int tb = 0; tb < 2; ++tb)
#pragma unroll
            for (int r = 0; r < 16; ++r) oT[tb][r] = 0.f;
        if (FULL) {
#pragma unroll
        for (int db = 0; db < 4; ++db)
#pragma unroll
            for (int s = 0; s < 2; ++s) { const bf16x8 sf = PACK_STEP(sacc[db], s);
#pragma unroll
                for (int tb = 0; tb < 2; ++tb) { const LAS unsigned char* qb = lds + GL_QE + (32 * tb + n) * GL_QS + (32 * db + 16 * s + 4 * hh) * 2;
                    const s16x4 lo = *(const LAS s16x4*)qb, hi = *(const LAS s16x4*)(qb + 16); const bf16x8 bq = __builtin_shufflevector(lo, hi, 0, 1, 2, 3, 4, 5, 6, 7);
                    oT[tb] = MFMA32(sf, bq, oT[tb]); } }
        }
        bf16x8 vf[2][2];
#pragma unroll
        for (int sb = 0; sb < 2; ++sb)
#pragma unroll
            for (int s2 = 0; s2 < 2; ++s2) vf[sb][s2] = trfrag(vtr_base + (32 * sb + 16 * s2) * GL_VS, 8 * GL_VS);
        if (FULL) {
#pragma unroll
        for (int blk3 = 0; blk3 < 3; ++blk3) { const int sb = blk3 >> 1, tb = (blk3 + 1) >> 1;
            f32x16 pt;
#pragma unroll
            for (int r = 0; r < 16; ++r) pt[r] = 0.f;
#pragma unroll
            for (int ks = 0; ks < 8; ++ks) { const bf16x8 ka = *(const LAS bf16x8*)(lds + GL_KE + (32 * sb + n) * GL_QS + (16 * ks + 8 * hh) * 2);
                const bf16x8 qb = *(const LAS bf16x8*)(lds + GL_QE + (32 * tb + n) * GL_QS + (16 * ks + 8 * hh) * 2); pt = MFMA32(ka, qb, pt); }
            if (sb == tb) {
#pragma unroll
                for (int r = 0; r < 16; ++r) pt[r] = (crow(r, hh) <= n) ? pt[r] : 0.f; }
            const bf16x8 p0 = PACK_STEP(pt, 0), p1 = PACK_STEP(pt, 1);
            oT[tb] = MFMA32(vf[sb][0], p0, oT[tb]); oT[tb] = MFMA32(vf[sb][1], p1, oT[tb]); }
        }
#pragma unroll
        for (int db = 0; db < 4; ++db) {
#pragma unroll
            for (int g = 0; g < 4; ++g) { const f32x4 e4 = *(const LAS f32x4*)(EB + 32 * db + 8 * g + 4 * hh);
                sacc[db][4 * g] *= e4.x; sacc[db][4 * g + 1] *= e4.y; sacc[db][4 * g + 2] *= e4.z; sacc[db][4 * g + 3] *= e4.w; }
#pragma unroll
            for (int sb = 0; sb < 2; ++sb)
#pragma unroll
                for (int s2 = 0; s2 < 2; ++s2) { const bf16x8 kdf = trfrag(kdtr_base + (32 * sb + 16 * s2) * GL_QS + 64 * db, 8 * GL_QS); sacc[db] = MFMA32(kdf, vf[sb][s2], sacc[db]); } }
        if (!FULL) { __syncthreads(); continue; }
#pragma unroll
        for (int tb = 0; tb < 2; ++tb) { float ss = 0.f;
#pragma unroll
            for (int r = 0; r < 16; ++r) ss += oT[tb][r] * oT[tb][r];
            ss += __shfl_xor(ss, 32); if (hh == 0) SSQ[wave * 64 + 32 * tb + n] = ss; }
        __syncthreads();
#pragma unroll
        for (int tb = 0; tb < 2; ++tb) { const int t = 32 * tb + n; float tot = 0.f;
#pragma unroll
            for (int w8 = 0; w8 < 8; ++w8) tot += SSQ[w8 * 64 + t];
            const float rstd = 1.0f / sqrtf(tot * (1.0f / 256.0f) + LN_EPS); bf16* rowp = H + (m0 + t) * HW;
#pragma unroll
            for (int g = 0; g < 4; ++g) { const int col = hg * 256 + 32 * wave + 8 * g + 4 * hh;
                const v2u gg = *(const v2u*)(rowp + C_GG + col), ma = *(const v2u*)(rowp + C_MA + col), os = *(const v2u*)(rowp + C_SQ + col); const f32x4 gn = *(const f32x4*)(gng + col);
                const float x0 = __uint_as_float(gg.x << 16), x1 = __uint_as_float(gg.x & 0xffff0000u), x2 = __uint_as_float(gg.y << 16), x3 = __uint_as_float(gg.y & 0xffff0000u);
                const float a0 = __uint_as_float(ma.x << 16), a1 = __uint_as_float(ma.x & 0xffff0000u), a2 = __uint_as_float(ma.y << 16), a3 = __uint_as_float(ma.y & 0xffff0000u);
                const float o0 = oT[tb][4 * g] * rstd * gn.x * (x0 * sigmoidf_(x0)) * sigmoidf_(a0), o1 = oT[tb][4 * g + 1] * rstd * gn.y * (x1 * sigmoidf_(x1)) * sigmoidf_(a1);
                const float o2 = oT[tb][4 * g + 2] * rstd * gn.z * (x2 * sigmoidf_(x2)) * sigmoidf_(a2), o3 = oT[tb][4 * g + 3] * rstd * gn.w * (x3 * sigmoidf_(x3)) * sigmoidf_(a3);
                v2u o; o.x = cvtpk(o0 + __uint_as_float(os.x << 16), o1 + __uint_as_float(os.x & 0xffff0000u)); o.y = cvtpk(o2 + __uint_as_float(os.y << 16), o3 + __uint_as_float(os.y & 0xffff0000u)); *(v2u*)(rowp + C_GG + col) = o; } }
    }
    if (!FULL) {
        float* Lp = Lst + (size_t)unit * GL_STATE + (size_t)wave * 4 * 16 * 64 + lane;
#pragma unroll
        for (int db = 0; db < 4; ++db)
#pragma unroll
            for (int r = 0; r < 16; ++r) Lp[(db * 16 + r) * 64] = sacc[db][r];
        if (tid < 128) Lsum[unit * 128 + tid] = lsum;
    }
}
#define RLX_AGENT __ATOMIC_RELAXED, __HIP_MEMORY_SCOPE_AGENT
#define XB_TMO      128
#define XB_XCNT(j)  (256  + 64 * (j))
#define XB_XSUB(j)  (1280 + 64 * (j))
#define XB_XGEN(j)  (2304 + 64 * (j))
#define XB_TOP      3328
#define XB_TOPGEN   3392
#define XCD_BAR_WORDS 3456
#define XB_SPIN_CAP (1u << 18)
#define XBW(bar, i) ((bar) + (size_t)((unsigned)(i) >> 7) * xb_stride + ((unsigned)(i) & 127u))

__device__ __forceinline__ unsigned xb_ld(unsigned* p)              { return __hip_atomic_load(p, __ATOMIC_RELAXED, __HIP_MEMORY_SCOPE_AGENT); }
__device__ __forceinline__ unsigned xb_add(unsigned* p, unsigned v) { return __hip_atomic_fetch_add(p, v, __ATOMIC_RELAXED, __HIP_MEMORY_SCOPE_AGENT); }
__device__ __forceinline__ unsigned xb_xcc_id() { return (unsigned)__builtin_amdgcn_s_getreg((3 << 11) | 20) & 0xFu; }
#define XB_SPIN(cond, bar) do { unsigned _sp = 0; while (cond) { __builtin_amdgcn_s_sleep(1); \
    if ((++_sp & 255u) == 0u) { if (xb_ld(XBW(bar, XB_TMO))) break; if (_sp > XB_SPIN_CAP) { atomicAdd(XBW(bar, XB_TMO), 1u); break; } } } } while (0)

struct XcdBarrier {
    unsigned xb_stride;
    unsigned* bar; unsigned x;
    volatile LAS unsigned* st;
};

__device__ __forceinline__ XcdBarrier xcd_barrier_post(unsigned* bar, volatile LAS unsigned* st, unsigned xb_stride) {
    XcdBarrier b; b.xb_stride = xb_stride; b.bar = bar; b.x = xb_xcc_id(); b.st = st;
    if (threadIdx.x == 0) (void)xb_add(XBW(bar, XB_XCNT(b.x)), 1u);
    return b;
}
__device__ __forceinline__ void xcd_barrier_complete(unsigned* bar, unsigned xb_stride, unsigned x, unsigned& nloc, unsigned& nx) {
    const unsigned G = gridDim.x * gridDim.y * gridDim.z;
    unsigned sum, cnt, mine, sp = 0u;
    for (;;) {
        sum = 0u; cnt = 0u; mine = 0u;
#pragma unroll
        for (unsigned j = 0; j < 16; ++j) { const unsigned c = xb_ld(XBW(bar, XB_XCNT(j))); sum += c; cnt += (c > 0u) ? 1u : 0u; mine = (j == x) ? c : mine; }
        if (sum == G) break;
        __builtin_amdgcn_s_sleep(1);
        if ((++sp & 255u) == 0u) { if (xb_ld(XBW(bar, XB_TMO))) break; if (sp > XB_SPIN_CAP) { atomicAdd(XBW(bar, XB_TMO), 1u); break; } }
    }
    nloc = mine > 0u ? mine : 1u; nx = cnt > 0u ? cnt : 1u;
}

__device__ __forceinline__ void xcd_barrier(const XcdBarrier& b) {
    asm volatile("s_waitcnt vmcnt(0)" ::: "memory");
    __syncthreads();
    if (threadIdx.x == 0) {
        unsigned* bar = b.bar; const unsigned xb_stride = b.xb_stride;
        __builtin_amdgcn_s_waitcnt(0);
        unsigned nloc = b.st[0], nx = b.st[1];
        if (nloc == 0u) { xcd_barrier_complete(bar, xb_stride, b.x, nloc, nx); b.st[0] = nloc; b.st[1] = nx; }
        const unsigned old = xb_add(XBW(bar, XB_XSUB(b.x)), 1u);
        const unsigned gen = old / nloc;
        if (old + 1u == (gen + 1u) * nloc) {
            __builtin_amdgcn_fence(__ATOMIC_RELEASE, "agent");
            asm volatile("s_waitcnt vmcnt(0)" ::: "memory");
            const unsigned og = xb_add(XBW(bar, XB_TOP), 1u);
            const unsigned tg = og / nx;
            if (og + 1u == (tg + 1u) * nx) xb_add(XBW(bar, XB_TOPGEN), 1u);
            else XB_SPIN(xb_ld(XBW(bar, XB_TOPGEN)) == tg, bar);
            __builtin_amdgcn_fence(__ATOMIC_ACQUIRE, "agent");
            xb_add(XBW(bar, XB_XGEN(b.x)), 1u);
            asm volatile("s_waitcnt vmcnt(0)" ::: "memory");
        } else {
            XB_SPIN(xb_ld(XBW(bar, XB_XGEN(b.x))) == gen, bar);
            __builtin_amdgcn_fence(__ATOMIC_ACQUIRE, "agent");
            asm volatile("s_waitcnt vmcnt(0)" ::: "memory");
        }
    }
    __syncthreads();
}

constexpr size_t DO_BAR = 107 * MiB;
constexpr int MISC_OFF = LDS_BYTES - 256;
constexpr unsigned XBB_WORD0 = 1920u, XBB_STRIDE = 4096u;
__global__ void __launch_bounds__(NTHR, 2) fwd_megakernel(Args args) {
    extern __shared__ __attribute__((aligned(16))) unsigned char lds_raw[];
    cg::grid_group grid = cg::this_grid();
    LAS unsigned char* lds = (LAS unsigned char*)lds_raw;
    const int tid = threadIdx.x, lane = tid & 63, wave = __builtin_amdgcn_readfirstlane(tid >> 6);
    const int G = gridDim.x, bx = blockIdx.x;
    const float* x = args.in[0]; const float* cvec = args.in[1]; const float* w_ada = args.in[2]; const float* b_ada = args.in[3]; const float* w_in = args.in[4];
    const float* w_up = args.in[5]; const float* b_alpha = args.in[6]; const float* gng = args.in[7]; const float* w_out = args.in[8];
    const float* ln1_g = args.in[9]; const float* ln1_b = args.in[10]; const float* w_ffin = args.in[11]; const float* w_ffout = args.in[12]; const float* ln2_g = args.in[13]; const float* ln2_b = args.in[14];
    unsigned char* dsc = (unsigned char*)args.out;
    bf16* H = (bf16*)args.ws; float* Hf = (float*)args.ws;
    bf16* U1 = (bf16*)(dsc + DO_U1); bf16* Wt_in = (bf16*)(dsc + DO_WIN); bf16* Wt_out = (bf16*)(dsc + DO_WOUT); bf16* Wt_ffin = (bf16*)(dsc + DO_WFFIN); bf16* Wt_ffout = (bf16*)(dsc + DO_WFFOUT);
    bf16* GA = (bf16*)(dsc + DO_GA); float* Lst = (float*)(dsc + DO_U1); float* Lsum = (float*)(dsc + DO_U1 + 32 * MiB); float* modp = (float*)(dsc + DO_MODP); float* modf = (float*)(dsc + DO_MODF);

    volatile LAS unsigned* MISC = (volatile LAS unsigned*)(lds + MISC_OFF);
    if (tid < 64) MISC[tid] = 0u;
    __syncthreads();
    const XcdBarrier xbar = xcd_barrier_post((unsigned*)(dsc + DO_BAR), MISC, 128u);
    unsigned* const barB = (unsigned*)args.ws + XBB_WORD0;
    {
        LAS float* scr = (LAS float*)(lds + wave * 16384);
        const int gw = bx * NWAVES + wave, NGW = G * NWAVES;
        constexpr int I_ADA = 96 * 16, I_IN = (8224 / 32) * (D / 64), I_OUT = (D / 32) * (D / 64), I_FI = (2 * FF / 32) * (D / 64), I_FO = (D / 32) * (FF / 64);
        constexpr int NITEMS = I_ADA + I_IN + I_OUT + I_FI + I_FO;
        for (int it = gw; it < NITEMS; it += NGW) {
            int r = it;
            if (r < I_ADA) {
                const int cgp = r % 96, ks = r / 96, col = 64 * cgp + lane, k0 = 64 * ks;
                float sc[8], acc[8];
#pragma unroll
                for (int b = 0; b < 8; ++b) { const float cv = cvec[b * D + k0 + lane]; sc[b] = cv * sigmoidf_(cv); acc[b] = 0.f; }
#pragma unroll 8
                for (int kk = 0; kk < 64; ++kk) { const float w = w_ada[(size_t)(k0 + kk) * NMOD + col];
#pragma unroll
                    for (int b = 0; b < 8; ++b) acc[b] += __shfl(sc[b], kk) * w; }
#pragma unroll
                for (int b = 0; b < 8; ++b) modp[(size_t)(ks * 8 + b) * NMOD + col] = acc[b];
                continue;
            }
            r -= I_ADA;
            if (r < I_IN) { transpose_item(w_in, 8208, Wt_in, D, 32 * (r % (8224 / 32)), 64 * (r / (8224 / 32)), 0, false, scr, lane); continue; } r -= I_IN;
            if (r < I_OUT) { transpose_item(w_out, D, Wt_out, D, 32 * (r % (D / 32)), 64 * (r / (D / 32)), 2, false, scr, lane); continue; } r -= I_OUT;
            if (r < I_FI) { transpose_item(w_ffin, 2 * FF, Wt_ffin, D, 32 * (r % (2 * FF / 32)), 64 * (r / (2 * FF / 32)), 1, false, scr, lane); continue; } r -= I_FI;
            transpose_item(w_ffout, D, Wt_ffout, FF, 32 * (r % (D / 32)), 64 * (r / (D / 32)), 2, false, scr, lane);
        }
    }
    grid.sync();

    {
        for (int idx = bx * NTHR + tid; idx < BATCH * NMOD; idx += G * NTHR) { const int b = idx / NMOD, j = idx % NMOD; float s = b_ada[j];
#pragma unroll
            for (int ks = 0; ks < 16; ++ks) s += modp[(size_t)(ks * 8 + b) * NMOD + j];
            modf[idx] = s; }
        LAS float* ssh = (LAS float*)lds; LAS float* ssc = ssh + D;
        constexpr int WGA_OFF = 16384, WGA_RS = 2064;
        for (int e = tid; e < 16 * 128; e += NTHR) { const int r = e >> 7, ch = e & 127; *(LAS v4u*)(lds + WGA_OFF + r * WGA_RS + ch * 16) = *(const v4u*)(Wt_in + (size_t)(8192 + r) * D + ch * 8); }
        for (int rg = bx; rg < M / 128; rg += G) {
            const int b = rg / (SEQ / 128);
            __syncthreads();
            for (int j = tid; j < 2 * D; j += NTHR) { float s = b_ada[j];
#pragma unroll
                for (int ks = 0; ks < 16; ++ks) s += modp[(size_t)(ks * 8 + b) * NMOD + j];
                ssh[j] = s; }
            __syncthreads();
            for (int i = 0; i < 16; i += 4) { const size_t row0 = (size_t)rg * 128 + wave * 16 + i; f32x4 v[4][4];
#pragma unroll
                for (int r = 0; r < 4; ++r) { const f32x4* xr = (const f32x4*)(x + (row0 + r) * D) + lane;
#pragma unroll
                    for (int j = 0; j < 4; ++j) v[r][j] = xr[64 * j]; }
#pragma unroll
                for (int r = 0; r < 4; ++r) { float rstd; row_stats(v[r], rstd);
                    unsigned long long* o8 = (unsigned long long*)(U1 + (row0 + r) * D) + lane;
#pragma unroll
                    for (int j = 0; j < 4; ++j) { const int c0 = 4 * lane + 256 * j; const f32x4 sc = *(const LAS f32x4*)(ssc + c0), sh = *(const LAS f32x4*)(ssh + c0);
                        const f32x4 o = v[r][j] * rstd * (sc + 1.0f) + sh; o8[64 * j] = (unsigned long long)cvtpk(o.x, o.y) | ((unsigned long long)cvtpk(o.z, o.w) << 32); } } }
            { asm volatile("s_waitcnt vmcnt(0)" ::: "memory");
              const size_t row0 = (size_t)rg * 128 + wave * 16; const int ar = lane & 15, kq = lane >> 4;
              const bf16* ap = U1 + (row0 + ar) * D + 8 * kq; const LAS unsigned char* bp = lds + WGA_OFF + ar * WGA_RS + 16 * kq;
              pg8::f32x4 acc0 = {0.f, 0.f, 0.f, 0.f}, acc1 = {0.f, 0.f, 0.f, 0.f};
#pragma unroll 4
              for (int s = 0; s < 32; s += 2) { const bf16x8 a0 = *(const bf16x8*)(ap + 32 * s), a1 = *(const bf16x8*)(ap + 32 * s + 32);
                  const bf16x8 b0 = *(const LAS bf16x8*)(bp + 64 * s), b1 = *(const LAS bf16x8*)(bp + 64 * s + 64);
                  acc0 = __builtin_amdgcn_mfma_f32_16x16x32_bf16(a0, b0, acc0, 0, 0, 0); acc1 = __builtin_amdgcn_mfma_f32_16x16x32_bf16(a1, b1, acc1, 0, 0, 0); }
#pragma unroll
              for (int r = 0; r < 4; ++r) GA[(row0 + 4 * kq + r) * 16 + ar] = (bf16)(cvtpk(acc0[r] + acc1[r], 0.f) & 0xffffu); }
        }
    }
    xcd_barrier(xbar);

    { pg8::Gemm g{U1, Wt_in, M, HW, D, D}; pg8::StaticOrder S; S.init(M, HW, G, bx); pg8::EpiH E{H, GA};
      pg8::gemm_phase<pg8::EpiH, pg8::StaticOrder, PG8_ALIGN, PG8_SP2>(lds, g, S, E); }
    xcd_barrier(xbar);

    {
        for (int unit = bx; unit < BATCH * 4 * GL_NSEG; unit += G) { if ((unit & 7) != 7) { int t_ = tid; asm volatile("" : "+v"(t_)); gla_seg<false>(H, GA, w_up, b_alpha, gng, Lst, Lsum, lds, unit, t_); } __syncthreads(); }
        LAS unsigned char* wl = lds + wave * (64 * SB_KS);
        unsigned* sbq = (unsigned*)(dsc + DO_BAR + 8192);
        for (;;) { unsigned u = 0u; if (lane == 0) u = atomicAdd(sbq, 1u); u = (unsigned)__builtin_amdgcn_readfirstlane((int)u); if (u >= (unsigned)(BATCH * 8 * (SEQ / 32))) break;
            const int qt = 127 - (int)(u & 127u), bh = (int)(u >> 7); int l_ = lane; asm volatile("" : "+v"(l_)); sb_unit(H, wl, bh >> 3, bh & 7, qt, l_); }
    }
    xcd_barrier(xbar);
    for (int unit = bx; unit < BATCH * 4 * GL_NSEG; unit += G) { __syncthreads(); int t_ = tid; asm volatile("" : "+v"(t_)); gla_seg<true>(H, GA, w_up, b_alpha, gng, Lst, Lsum, lds, unit, t_); }
    xcd_barrier(xbar);

    { pg8::Gemm g{H + C_GG, Wt_out, M, D, D, HW}; pg8::StaticOrder S; S.init(M, D, G, bx); pg8::EpiRes<false> E{x, D, H + C_R, HW, modf + 2 * D, ALPHA};
      pg8::gemm_phase<pg8::EpiRes<false>, pg8::StaticOrder, PG8_ALIGN, PG8_SP2>(lds, g, S, E); }
    xcd_barrier(xbar);

    {
        LAS float* sg = (LAS float*)lds; LAS float* sb_ = sg + D; LAS float* ssh = sb_ + D; LAS float* ssc = ssh + D;
        if (bx == 0) { const unsigned xb_stride = XBB_STRIDE; for (unsigned i = tid; i < (unsigned)XCD_BAR_WORDS; i += NTHR) *XBW(barB, i) = 0u; }
        for (int rg = bx; rg < M / 128; rg += G) {
            const int b = rg / (SEQ / 128);
            __syncthreads();
            for (int j = tid; j < D; j += NTHR) { sg[j] = ln1_g[j]; sb_[j] = ln1_b[j]; ssh[j] = modf[(size_t)b * NMOD + 3 * D + j]; ssc[j] = modf[(size_t)b * NMOD + 4 * D + j]; }
            __syncthreads();
            for (int i = 0; i < 16; i += 2) { const size_t row0 = (size_t)rg * 128 + wave * 16 + i; f32x4 v[2][4];
#pragma unroll
                for (int r = 0; r < 2; ++r) { const v2u* rr = (const v2u*)(H + (row0 + r) * HW + C_R) + lane;
#pragma unroll
                    for (int j = 0; j < 4; ++j) v[r][j] = bf4_to_f32(rr[64 * j]); }
#pragma unroll
                for (int r = 0; r < 2; ++r) { const size_t row = row0 + r; float rstd; row_stats(v[r], rstd);
                    v2u* x1o = (v2u*)(H + row * HW + C_X1) + lane;
#pragma unroll
                    for (int j = 0; j < 4; ++j) { const int c0 = 4 * lane + 256 * j; v[r][j] = v[r][j] * rstd * *(const LAS f32x4*)(sg + c0) + *(const LAS f32x4*)(sb_ + c0); v2u p; p.x = cvtpk(v[r][j].x, v[r][j].y); p.y = cvtpk(v[r][j].z, v[r][j].w); x1o[64 * j] = p; }
                    row_stats(v[r], rstd);
                    unsigned long long* o8 = (unsigned long long*)(U1 + row * D) + lane;
#pragma unroll
                    for (int j = 0; j < 4; ++j) { const int c0 = 4 * lane + 256 * j; const f32x4 o = v[r][j] * rstd * (*(const LAS f32x4*)(ssc + c0) + 1.0f) + *(const LAS f32x4*)(ssh + c0);
                        o8[64 * j] = (unsigned long long)cvtpk(o.x, o.y) | ((unsigned long long)cvtpk(o.z, o.w) << 32); } } }
        }
    }
    xcd_barrier(xbar);

    const XcdBarrier xbarB = xcd_barrier_post(barB, MISC + 2, XBB_STRIDE);
    { pg8::Gemm g{U1, Wt_ffin, M, 2 * FF, D, D}; pg8::StaticOrder S; S.init(M, 2 * FF, G, bx); pg8::EpiSwiglu E{H + C_ACT, HW};
      pg8::gemm_phase<pg8::EpiSwiglu, pg8::StaticOrder, PG8_ALIGN, PG8_SP2>(lds, g, S, E); }
    xcd_barrier(xbar);

    { pg8::Gemm g{H + C_ACT, Wt_ffout, M, D, FF, HW}; pg8::StaticOrder S; S.init(M, D, G, bx); pg8::EpiRes<true> E{H + C_X1, HW, H + C_R, HW, modf + 5 * D, ALPHA};
      pg8::gemm_phase<pg8::EpiRes<true>, pg8::StaticOrder, PG8_ALIGN, PG8_SP2>(lds, g, S, E); }
    xcd_barrier(xbarB);

    {
        const size_t rstep = (size_t)G * NWAVES;
        for (size_t row0 = (size_t)bx * NWAVES + wave; row0 < (size_t)M; row0 += 4 * rstep) { f32x4 v[4][4];
#pragma unroll
            for (int r = 0; r < 4; ++r) { const size_t row = row0 + r * rstep; if (row < (size_t)M) { const v2u* rr = (const v2u*)(H + row * HW + C_R) + lane;
#pragma unroll
                for (int j = 0; j < 4; ++j) v[r][j] = bf4_to_f32(rr[64 * j]); } }
#pragma unroll
            for (int r = 0; r < 4; ++r) { const size_t row = row0 + r * rstep; if (row < (size_t)M) { float rstd; row_stats(v[r], rstd);
                f32x4* oo = (f32x4*)(args.out + row * D) + lane;
#pragma unroll
                for (int j = 0; j < 4; ++j) { const int c0 = 4 * lane + 256 * j; oo[64 * j] = v[r][j] * rstd * *(const f32x4*)(ln2_g + c0) + *(const f32x4*)(ln2_b + c0); } } }
        }
    }
}

extern "C" void kernel_launch(void* const* d_in, const int* in_sizes, int n_in, void* d_out, int out_size, void* d_ws, size_t ws_size, hipStream_t stream) {
    static int grid = 0;
    if (grid == 0) {
        if (n_in != 15 || out_size != M * D || ws_size < (size_t)M * HW * 2) { fprintf(stderr, "kernel_launch: unexpected problem shape (n_in %d, out %d, ws %zu)\n", n_in, out_size, ws_size); grid = -1; return; }
        int dev = 0, cus = 0, per_cu = 0;
        if (hipGetDevice(&dev) != hipSuccess || hipDeviceGetAttribute(&cus, hipDeviceAttributeMultiprocessorCount, dev) != hipSuccess) { grid = -1; return; }
        if (hipFuncSetAttribute((const void*)fwd_megakernel, hipFuncAttributeMaxDynamicSharedMemorySize, LDS_BYTES) != hipSuccess) { fprintf(stderr, "kernel_launch: hipFuncSetAttribute failed\n"); grid = -1; return; }
        if (hipOccupancyMaxActiveBlocksPerMultiprocessor(&per_cu, (const void*)fwd_megakernel, NTHR, LDS_BYTES) != hipSuccess || per_cu < 1) { fprintf(stderr, "kernel_launch: occupancy query gave %d\n", per_cu); per_cu = 1; }
        (void)hipGetLastError();
        grid = cus * per_cu;
    }
    if (grid < 0) return;
    if (hipMemsetAsync((char*)d_out + DO_BAR, 0, 16384, stream) != hipSuccess) { fprintf(stderr, "kernel_launch: memset failed\n"); return; }
    Args a{};
    for (int i = 0; i < 15; ++i) a.in[i] = (const float*)d_in[i];
    a.out = (float*)d_out; a.ws = (unsigned char*)d_ws;
    void* kargs[] = {&a};
    const hipError_t e = hipLaunchCooperativeKernel((const void*)fwd_megakernel, dim3(grid), dim3(NTHR), kargs, LDS_BYTES, stream);
    if (e != hipSuccess) fprintf(stderr, "kernel_launch: cooperative launch failed: %s (grid %d)\n", hipGetErrorString(e), grid);
}
```
